# Optimizing an MI355X kernel written in HIP

```python
import jax, jax.numpy as jnp
from jax import lax
import numpy as np

D_MODEL = 1024
BATCH = 8
SEQ = 4096
DEPTH = 4

N_HEADS = 8
HEAD_DIM = 64
ATTN_WIDTH = N_HEADS * HEAD_DIM
KV_LATENT = 128
IDX_HEADS = 4
IDX_DIM = 32
TOPK_MAX = 256
Q_BLOCK = 128
ATTN_SCALE = HEAD_DIM ** -0.5
IDX_W_SCALE = (IDX_HEADS ** -0.5) * (IDX_DIM ** -0.5)
POOL_WINDOWS = (2, 4, 8, 16)
POOL_GROUPS = 4
POOL_GROUP_DIM = 128
POOL_WIDTH = POOL_GROUPS * POOL_GROUP_DIM
N_EXPERTS = 32
TOP_K = 4
D_FF = D_MODEL // 2
MOE_BLOCK = 512
SWIGLU_LIMIT = 7.0
SWIGLU_ALPHA = 1.702
RMS_EPS = 1e-6
COL_WIDTHS = (ATTN_WIDTH, KV_LATENT, IDX_HEADS * IDX_DIM, IDX_DIM, IDX_HEADS, POOL_WIDTH, D_MODEL, D_MODEL)
IN_WIDTH = sum(COL_WIDTHS)
SPLIT_OFFSETS = tuple(int(v) for v in np.cumsum(COL_WIDTHS)[:-1])

kernel_name = 'hybrid_dsa_pool_moe_adaln'


def rms_norm(x, g):
    xf = x.astype(jnp.float32)
    y = xf * lax.rsqrt(jnp.mean(xf * xf, axis=-1, keepdims=True) + RMS_EPS)
    return (y * g.astype(jnp.float32)).astype(x.dtype)


def dsa_attention(q, ckv, qi, ki, wi, w_uk, w_uv):
    b_, L = q.shape[0], q.shape[1]
    k_sel = min(TOPK_MAX, L // 4)
    nb = L // Q_BLOCK
    key_pos = jnp.arange(L, dtype=jnp.int32)

    def to_blocks(t):
        return jnp.moveaxis(t.reshape((b_, nb, Q_BLOCK) + t.shape[2:]), 1, 0)

    def block(args):
        q_b, qi_b, wi_b, start = args
        qpos = start + jnp.arange(Q_BLOCK, dtype=jnp.int32)
        causal = key_pos[None, :] <= qpos[:, None]
        raw = jnp.einsum('bqhd,bsd->bqhs', qi_b, ki, preferred_element_type=jnp.float32)
        score = jnp.einsum('bqhs,bqh->bqs', jax.nn.relu(raw), wi_b.astype(jnp.float32) * IDX_W_SCALE)
        score = jnp.where(causal[None], score, -jnp.inf)
        _, idx = lax.top_k(score, k_sel)
        valid = idx <= qpos[None, :, None]
        kv_sel = jax.vmap(lambda kv, i: kv[i])(ckv, idx)
        q_lat = jnp.einsum('bqhd,lhd->bqhl', q_b, w_uk)
        logits = jnp.einsum('bqhl,bqkl->bqhk', q_lat, kv_sel, preferred_element_type=jnp.float32) * ATTN_SCALE
        logits = jnp.where(valid[:, :, None, :], logits, -jnp.inf)
        p = jax.nn.softmax(logits, axis=-1).astype(kv_sel.dtype)
        o_lat = jnp.einsum('bqhk,bqkl->bqhl', p, kv_sel)
        return jnp.einsum('bqhl,lhd->bqhd', o_lat, w_uv)

    starts = jnp.arange(nb, dtype=jnp.int32) * Q_BLOCK
    out = lax.map(block, (to_blocks(q), to_blocks(qi), to_blocks(wi), starts))
    return jnp.moveaxis(out, 0, 1).reshape(b_, L, ATTN_WIDTH)


def multiscale_pool(a, w_pool, pool_scale):
    b_, L, _ = a.shape
    af = a.astype(jnp.float32)
    cs = jnp.cumsum(af, axis=1)
    pos = jnp.arange(1, L + 1, dtype=jnp.float32)
    outs = []
    for g, w in enumerate(POOL_WINDOWS):
        sl = slice(g * POOL_GROUP_DIM, (g + 1) * POOL_GROUP_DIM)
        cs_g = cs[..., sl]
        prev = jnp.pad(cs_g, ((0, 0), (w, 0), (0, 0)))[:, :L]
        mean = (cs_g - prev) / jnp.minimum(pos, float(w))[:, None]
        outs.append(mean - af[..., sl])
    d = jnp.stack(outs, axis=2).astype(a.dtype)
    z = jnp.einsum('blgc,gcd->blgd', d, w_pool).reshape(b_, L, POOL_WIDTH)
    return z * pool_scale


def moe(h, w_router, b_router, w_gu, b_gu, w_down, b_down):
    b_, L, D = h.shape
    hf = h.reshape(b_ * L, D)
    n_tok = b_ * L
    n_asg = n_tok * TOP_K
    logits = (hf @ w_router + b_router).astype(jnp.float32)
    top_val, top_idx = lax.top_k(logits, TOP_K)
    wts = jax.nn.softmax(top_val, axis=-1)
    flat_e = top_idx.reshape(-1)
    order = jnp.argsort(flat_e)
    e_sorted = flat_e[order]
    tok = order // TOP_K
    w_sorted = wts.reshape(-1)[order]
    sizes = jnp.bincount(flat_e, length=N_EXPERTS).astype(jnp.int32)
    padded = ((sizes + MOE_BLOCK - 1) // MOE_BLOCK) * MOE_BLOCK
    start_unpad = jnp.cumsum(sizes) - sizes
    end_pad = jnp.cumsum(padded)
    start_pad = end_pad - padded
    rank = jnp.arange(n_asg, dtype=jnp.int32) - start_unpad[e_sorted]
    dest = start_pad[e_sorted] + rank
    n_blocks = -(-n_asg // MOE_BLOCK) + N_EXPERTS
    n_rows = n_blocks * MOE_BLOCK
    xs = jnp.zeros((n_rows, D), h.dtype).at[dest].set(hf[tok])
    blk_start = jnp.arange(n_blocks, dtype=jnp.int32) * MOE_BLOCK
    blk_e = jnp.minimum(jnp.searchsorted(end_pad, blk_start, side='right'), N_EXPERTS - 1)

    def expert_block(args):
        xb, e = args
        gu = xb @ w_gu[e] + b_gu[e]
        gt, up = gu[:, :D_FF], gu[:, D_FF:]
        gt = jnp.minimum(gt, SWIGLU_LIMIT)
        up = jnp.clip(up, -SWIGLU_LIMIT, SWIGLU_LIMIT)
        act = gt * jax.nn.sigmoid(SWIGLU_ALPHA * gt) * (up + 1.0)
        return act @ w_down[e] + b_down[e]

    ys = lax.map(expert_block, (xs.reshape(n_blocks, MOE_BLOCK, D), blk_e)).reshape(n_rows, D)
    y = ys[dest] * w_sorted[:, None].astype(ys.dtype)
    return jax.ops.segment_sum(y, tok, num_segments=n_tok).reshape(b_, L, D)


def setup_inputs(seed: int = 0) -> dict:
    key = jax.random.key(seed)
    ks = jax.random.split(key, 24)
    f32 = jnp.float32
    nrm = lambda k, shp, s: jax.random.normal(k, shp, f32) * s
    D = D_MODEL
    return {
        'x': nrm(ks[0], (BATCH, SEQ, D), 1.0),
        'c': nrm(ks[1], (BATCH, D), 1.0),
        'norm1_g': 1.0 + nrm(ks[2], (DEPTH, D), 0.05),
        'norm2_g': 1.0 + nrm(ks[3], (DEPTH, D), 0.05),
        'w_ada': nrm(ks[4], (DEPTH, D, 6 * D), 0.5 * D ** -0.5),
        'b_ada': nrm(ks[5], (DEPTH, 6 * D), 0.02),
        'w_in': nrm(ks[6], (DEPTH, D, IN_WIDTH), D ** -0.5),
        'kv_norm_g': 1.0 + nrm(ks[7], (DEPTH, KV_LATENT), 0.05),
        'w_uk': nrm(ks[8], (DEPTH, KV_LATENT, N_HEADS, HEAD_DIM), HEAD_DIM ** -0.5),
        'w_uv': nrm(ks[9], (DEPTH, KV_LATENT, N_HEADS, HEAD_DIM), KV_LATENT ** -0.5),
        'w_pool': nrm(ks[10], (DEPTH, POOL_GROUPS, POOL_GROUP_DIM, POOL_GROUP_DIM), POOL_GROUP_DIM ** -0.5),
        'pool_scale': 1.0 + nrm(ks[11], (DEPTH, POOL_WIDTH), 0.1),
        'w_a_up': nrm(ks[12], (DEPTH, ATTN_WIDTH, D), ATTN_WIDTH ** -0.5),
        'w_b_up': nrm(ks[13], (DEPTH, POOL_WIDTH, D), POOL_WIDTH ** -0.5),
        'w_out': nrm(ks[14], (DEPTH, D, D), D ** -0.5),
        'w_router': nrm(ks[15], (DEPTH, D, N_EXPERTS), D ** -0.5),
        'b_router': nrm(ks[16], (DEPTH, N_EXPERTS), 0.01),
        'w_gu': nrm(ks[17], (DEPTH, N_EXPERTS, D, 2 * D_FF), D ** -0.5),
        'b_gu': nrm(ks[18], (DEPTH, N_EXPERTS, 2 * D_FF), 0.02),
        'w_down': nrm(ks[19], (DEPTH, N_EXPERTS, D_FF, D), D_FF ** -0.5),
        'b_down': nrm(ks[20], (DEPTH, N_EXPERTS, D), 0.02),
        'final_g': 1.0 + nrm(ks[21], (D,), 0.05),
    }


def reference(x, c, norm1_g, norm2_g, w_ada, b_ada, w_in, kv_norm_g, w_uk, w_uv, w_pool, pool_scale,
              w_a_up, w_b_up, w_out, w_router, b_router, w_gu, b_gu, w_down, b_down, final_g):
    b_, L, _ = x.shape
    cond = jax.nn.silu(c)
    for l in range(DEPTH):
        ada = (cond @ w_ada[l] + b_ada[l])[:, None, :]
        sh1, sc1, g1, sh2, sc2, g2 = jnp.split(ada, 6, axis=-1)
        h = rms_norm(x, norm1_g[l]) * (1.0 + sc1) + sh1
        p = h @ w_in[l]
        q, ckv, qi, ki, wi, a_pool, gate_a, gate_b = jnp.split(p, SPLIT_OFFSETS, axis=-1)
        q = q.reshape(b_, L, N_HEADS, HEAD_DIM)
        qi = qi.reshape(b_, L, IDX_HEADS, IDX_DIM)
        ckv = rms_norm(ckv, kv_norm_g[l])
        o_a = dsa_attention(q, ckv, qi, ki, wi, w_uk[l], w_uv[l])
        o_b = multiscale_pool(a_pool, w_pool[l], pool_scale[l])
        merged = jax.nn.sigmoid(gate_a) * (o_a @ w_a_up[l]) + jax.nn.sigmoid(gate_b) * (o_b @ w_b_up[l])
        x = x + g1 * (merged @ w_out[l])
        h2 = rms_norm(x, norm2_g[l]) * (1.0 + sc2) + sh2
        x = x + g2 * moe(h2, w_router[l], b_router[l], w_gu[l], b_gu[l], w_down[l], b_down[l])
    return rms_norm(x, final_g)
```

```cpp
#include <hip/hip_runtime.h>
#include <cstdint>
#include <cstdio>
#include <cstring>

#ifndef MK_MULTI
#define MK_MULTI 0
#endif

#define GAS __attribute__((address_space(1)))
#define LAS __attribute__((address_space(3)))
typedef unsigned short bf16_t;
typedef short bf16x8 __attribute__((ext_vector_type(8)));
typedef short s16x4 __attribute__((ext_vector_type(4)));
typedef float f32x4 __attribute__((ext_vector_type(4)));
typedef unsigned u32x4 __attribute__((ext_vector_type(4)));
typedef unsigned u32x2 __attribute__((ext_vector_type(2)));

constexpr int NTOK = 32768, DM = 1024, SEQ = 4096, NBATCH = 8, DEPTH = 4;
constexpr int IN_W = 3364;
constexpr int SC_Q = 0, SC_CKV = 512, SC_QI = 640, SC_KI = 768, SC_WI = 800, SC_POOL = 804, SC_GA = 1316, SC_GB = 2340;
constexpr int PM_LD = 3584;
constexpr int PC_Q = 0, PC_POOL = 512, PC_CKV = 1024, PC_GA = 1280, PC_GB = 2304, PC_QI = 3328, PC_KI = 3456, PC_WI = 3488;
constexpr int IDX_LD = 256;
constexpr int NEXP = 32, TOPK = 4, DFF = 512;
constexpr int NASG = NTOK * TOPK;
constexpr int NROWS = NASG + NEXP * 256;
constexpr int MAXTILES = NROWS / 256;
constexpr float RMS_EPS = 1e-6f;
constexpr float LOG2E = 1.4426950408889634f;

constexpr size_t MiB = 1u << 20;
constexpr size_t WS_CTL = 0, CTL_BYTES = 1 * MiB;
constexpr size_t WS_ADA = 1 * MiB;
constexpr size_t WS_W = 2 * MiB, WL_BYTES = 110 * MiB;
constexpr size_t WO_INMAIN = 0, WO_INPREC = 6 * MiB + 512 * 1024, WO_WA = 8 * MiB, WO_WB = 9 * MiB, WO_WOUT = 10 * MiB, WO_WRP = 12 * MiB,
                 WO_WUK = 13 * MiB + 512 * 1024, WO_WUV = WO_WUK + 128 * 1024, WO_WPOOL = WO_WUV + 128 * 1024, WO_WGU = 14 * MiB, WO_WDN = 78 * MiB;
constexpr size_t WS_X = 442 * MiB, WS_X1 = 570 * MiB, WS_HC = 698 * MiB, WS_IDXP = 826 * MiB, WS_CKVN = 858 * MiB, WS_KIH = 866 * MiB, WS_KIL = 868 * MiB,
                 WS_OAB = 870 * MiB, WS_RT = 934 * MiB, WS_XS = 938 * MiB, WS_ACT = 1210 * MiB, WS_YS = 1346 * MiB, WS_END = 1618 * MiB;
constexpr size_t WS_T1 = WS_XS;
constexpr size_t WS_MG = WS_ACT;
constexpr size_t WS_P = WS_YS;
static_assert((size_t)NTOK * PM_LD * 2 <= 272 * MiB && (size_t)NROWS * 1024 * 2 <= 272 * MiB && (size_t)NROWS * 512 * 2 <= 136 * MiB, "ws map");
constexpr int CW_BAR = 4096;
constexpr int CW_MOE = 8192, CW_MOE_STRIDE = 1024;
constexpr int RING_BYTES = 131072;
constexpr int QL_OFF = RING_BYTES, IDXL_OFF = QL_OFF + 16384, MISC_OFF = IDXL_OFF + 4096;
constexpr int LDS_BYTES = MISC_OFF + 1024;
constexpr int NWAVES = 8, NTHREADS = 512;

typedef float f32x2_t __attribute__((ext_vector_type(2))); typedef __bf16 bf16x2_t __attribute__((ext_vector_type(2)));
__device__ __forceinline__ unsigned pk2(float lo, float hi) { f32x2_t v = {lo, hi}; bf16x2_t b = __builtin_convertvector(v, bf16x2_t); return __builtin_bit_cast(unsigned, b); }
__device__ __forceinline__ unsigned f2bf(float f) { return pk2(f, f) & 0xffffu; }
__device__ __forceinline__ float bf2f(unsigned b) { return __builtin_bit_cast(float, b << 16); }
__device__ __forceinline__ float dpp_f(float v, const int ctrl_sel) {
    const int x = __builtin_bit_cast(int, v);
    int r;
    if (ctrl_sel == 0) r = __builtin_amdgcn_update_dpp(0, x, 0xB1, 0xF, 0xF, true);
    else if (ctrl_sel == 1) r = __builtin_amdgcn_update_dpp(0, x, 0x4E, 0xF, 0xF, true);
    else if (ctrl_sel == 2) r = __builtin_amdgcn_update_dpp(0, x, 0x141, 0xF, 0xF, true);
    else r = __builtin_amdgcn_update_dpp(0, x, 0x140, 0xF, 0xF, true);
    return __builtin_bit_cast(float, r);
}
__device__ __forceinline__ float wave_sum(float v) {
    v += dpp_f(v, 0); v += dpp_f(v, 1); v += dpp_f(v, 2); v += dpp_f(v, 3);
    const int x = __builtin_bit_cast(int, v);
    const float r0 = __builtin_bit_cast(float, __builtin_amdgcn_readlane(x, 0)), r1 = __builtin_bit_cast(float, __builtin_amdgcn_readlane(x, 16)),
                r2 = __builtin_bit_cast(float, __builtin_amdgcn_readlane(x, 32)), r3 = __builtin_bit_cast(float, __builtin_amdgcn_readlane(x, 48));
    return (r0 + r1) + (r2 + r3);
}
__device__ __forceinline__ float shfl_xor_f(float v, int m, int lane) { return __builtin_bit_cast(float, __builtin_amdgcn_ds_bpermute((lane ^ m) << 2, __builtin_bit_cast(int, v))); }
__device__ __forceinline__ unsigned wave_sum_u32(unsigned v) {
    int s = (int)v;
    s += __builtin_amdgcn_update_dpp(0, s, 0xB1, 0xF, 0xF, true);
    s += __builtin_amdgcn_update_dpp(0, s, 0x4E, 0xF, 0xF, true);
    s += __builtin_amdgcn_update_dpp(0, s, 0x141, 0xF, 0xF, true);
    s += __builtin_amdgcn_update_dpp(0, s, 0x140, 0xF, 0xF, true);
    s += __builtin_amdgcn_update_dpp(0, s, 0x142, 0xA, 0xF, false);
    s += __builtin_amdgcn_update_dpp(0, s, 0x143, 0xC, 0xF, false);
    return (unsigned)__builtin_amdgcn_readlane(s, 63);
}
__device__ __forceinline__ unsigned wave_max_u32(unsigned v) {
    unsigned t;
    t = (unsigned)__builtin_amdgcn_update_dpp(0, (int)v, 0xB1, 0xF, 0xF, true); v = v > t ? v : t;
    t = (unsigned)__builtin_amdgcn_update_dpp(0, (int)v, 0x4E, 0xF, 0xF, true); v = v > t ? v : t;
    t = (unsigned)__builtin_amdgcn_update_dpp(0, (int)v, 0x141, 0xF, 0xF, true); v = v > t ? v : t;
    t = (unsigned)__builtin_amdgcn_update_dpp(0, (int)v, 0x140, 0xF, 0xF, true); v = v > t ? v : t;
    const unsigned r0 = (unsigned)__builtin_amdgcn_readlane((int)v, 0), r1 = (unsigned)__builtin_amdgcn_readlane((int)v, 16), r2 = (unsigned)__builtin_amdgcn_readlane((int)v, 32), r3 = (unsigned)__builtin_amdgcn_readlane((int)v, 48);
    const unsigned a = r0 > r1 ? r0 : r1, b = r2 > r3 ? r2 : r3; return a > b ? a : b;
}
__device__ __forceinline__ int fresh_lane() { int l; asm volatile("v_mbcnt_lo_u32_b32 %0, -1, 0\n\tv_mbcnt_hi_u32_b32 %0, -1, %0" : "=v"(l)); return l; }
__device__ __forceinline__ float sigmoidf_fast(float v) { return __builtin_amdgcn_rcpf(1.f + __builtin_amdgcn_exp2f(-v * LOG2E)); }

#define XB_TMO      128
#define XB_XCNT(j)  (256  + 64 * (j))
#define XB_XSUB(j)  (1280 + 64 * (j))
#define XB_XGEN(j)  (2304 + 64 * (j))
#define XB_TOP      3328
#define XB_TOPGEN   3392
#define XCD_BAR_WORDS 3456
#define XB_SPIN_CAP (1u << 20)
__device__ __forceinline__ unsigned xb_ld(unsigned* p)              { return __hip_atomic_load(p, __ATOMIC_RELAXED, __HIP_MEMORY_SCOPE_AGENT); }
__device__ __forceinline__ unsigned xb_add(unsigned* p, unsigned v) { return __hip_atomic_fetch_add(p, v, __ATOMIC_RELAXED, __HIP_MEMORY_SCOPE_AGENT); }
__device__ __forceinline__ unsigned xb_xcc_id() { return (unsigned)__builtin_amdgcn_s_getreg((3 << 11) | 20) & 0xFu; }
#define XB_SPIN(cond, bar) do { unsigned _sp = 0; while (cond) { __builtin_amdgcn_s_sleep(1); \
    if ((++_sp & 255u) == 0u) { if (xb_ld(&(bar)[XB_TMO])) break; if (_sp > XB_SPIN_CAP) { atomicAdd(&(bar)[XB_TMO], 1u); break; } } } } while (0)
struct XcdBarrier { unsigned* bar; unsigned x; volatile LAS unsigned* st; };
__device__ __forceinline__ XcdBarrier xcd_barrier_post(unsigned* bar, volatile LAS unsigned* st) {
    XcdBarrier b; b.bar = bar; b.x = xb_xcc_id(); b.st = st;
    if (threadIdx.x == 0) (void)xb_add(&bar[XB_XCNT(b.x)], 1u);
    return b;
}
__device__ __forceinline__ void xcd_barrier_complete(unsigned* bar, unsigned x, unsigned& nloc, unsigned& nx) {
    const unsigned G = gridDim.x * gridDim.y * gridDim.z;
    unsigned sum, cnt, mine, sp = 0u;
    for (;;) {
        sum = 0u; cnt = 0u; mine = 0u;
#pragma unroll
        for (unsigned j = 0; j < 16; ++j) { const unsigned c = xb_ld(&bar[XB_XCNT(j)]); sum += c; cnt += (c > 0u) ? 1u : 0u; mine = (j == x) ? c : mine; }
        if (sum == G) break;
        __builtin_amdgcn_s_sleep(1);
        if ((++sp & 255u) == 0u) { if (xb_ld(&bar[XB_TMO])) break; if (sp > XB_SPIN_CAP) { atomicAdd(&bar[XB_TMO], 1u); break; } }
    }
    nloc = mine > 0u ? mine : 1u; nx = cnt > 0u ? cnt : 1u;
}
__device__ __forceinline__ void xcd_barrier(const XcdBarrier& b) {
    asm volatile("s_waitcnt vmcnt(0)" ::: "memory");
    __syncthreads();
    if (threadIdx.x == 0) {
        unsigned* bar = b.bar; asm volatile("" : "+s"(bar));
        __builtin_amdgcn_s_waitcnt(0);
        unsigned nloc = b.st[0], nx = b.st[1];
        if (nloc == 0u) { xcd_barrier_complete(bar, b.x, nloc, nx); b.st[0] = nloc; b.st[1] = nx; }
        const unsigned old = xb_add(&bar[XB_XSUB(b.x)], 1u);
        const unsigned gen = old / nloc;
        if (old + 1u == (gen + 1u) * nloc) {
            __builtin_amdgcn_fence(__ATOMIC_RELEASE, "agent");
            asm volatile("s_waitcnt vmcnt(0)" ::: "memory");
            const unsigned og = xb_add(&bar[XB_TOP], 1u);
            const unsigned tg = og / nx;
            if (og + 1u == (tg + 1u) * nx) xb_add(&bar[XB_TOPGEN], 1u);
            else XB_SPIN(xb_ld(&bar[XB_TOPGEN]) == tg, bar);
            __builtin_amdgcn_fence(__ATOMIC_ACQUIRE, "agent");
            xb_add(&bar[XB_XGEN(b.x)], 1u);
            asm volatile("s_waitcnt vmcnt(0)" ::: "memory");
        } else {
            XB_SPIN(xb_ld(&bar[XB_XGEN(b.x)]) == gen, bar);
            __builtin_amdgcn_fence(__ATOMIC_ACQUIRE, "agent");
            asm volatile("s_waitcnt vmcnt(0)" ::: "memory");
        }
    }
    __syncthreads();
}

namespace pg8 {
constexpr int BM = 256, BK = 64, HALF = 128, HTB = HALF * BK * 2, NXCD = 8, WGM = 8;
__host__ __device__ __forceinline__ int lds_byte(int r, int c) { const int st = (r >> 4) * 2 + (c >> 5), rr = r & 15, cc = c & 31, ob = rr * 64 + cc * 2; return st * 1024 + (ob ^ (((ob >> 9) & 1) << 5)); }
__host__ __device__ __forceinline__ void stage_rc(int b, int& R, int& C) { const int st = b / 1024, sb = b % 1024, swz = sb ^ (((sb >> 9) & 1) << 5); R = (st >> 1) * 16 + swz / 64; C = (st & 1) * 32 + (swz % 64) / 2; }
__host__ __device__ __forceinline__ int perm32(int rho) { const int n = rho >> 4, i = rho & 15; return 8 * (i >> 2) + 4 * n + (i & 3); }

struct Unit { int pm, pn, pb; };
struct Gemm { const bf16_t* A; const bf16_t* Bt; int lda, ldb, K, kmaskA; const int* perm; };

struct StaticOrder {
    int nN, nwg, c, full;
    __device__ void init(int M, int N, int G_, int c_, int full_ = 1 << 20) { nN = N / BM; nwg = (M / BM) * nN; c = c_; full = full_; (void)G_; }
    __device__ bool next(int i, Unit& u) const {
        if (c < 0) return false;
        int L;
        if (i < full) L = i * 256 + c; else { if (c >= 128) return false; L = full * 256 + (i - full) * 128 + c; }
        if (L >= nwg) return false;
        const int q = nwg >> 3, wgid = (L & 7) * q + (L >> 3);
        const int nig = WGM * nN, gid = wgid / nig, rem = wgid - gid * nig;
        u.pm = gid * WGM + (rem & 7); u.pn = rem >> 3; u.pb = u.pn; return true;
    }
};
struct GroupedOrder {
    const int* tile_e; int T, G, c;
    __device__ bool next(int i, Unit& u) const {
        const int L = i * G + c; if (L >= 4 * T) return false;
        u.pm = L >> 2; u.pn = L & 3; u.pb = tile_e[u.pm] * 4 + u.pn; return true;
    }
};

template <class Epi, class Sched, bool GATHER = false>
__device__ __forceinline__ void gemm_phase(LAS unsigned char* lds, const Gemm g, const Sched& S, const Epi& E, const int wid) {
    const int lane = fresh_lane(), tid = wid * 64 + lane;
    const int wr = wid >> 2, wc = wid & 3, fr = lane & 15, fq = lane >> 4;
    const int K = g.K, nt = K / BK;
    int Rr[2], Cc[2];
    unsigned voB[2], voA[2][2], voAn[2][2];
#pragma unroll
    for (int i = 0; i < 2; ++i) { int R, C; stage_rc(tid * 16 + i * 8192, R, C); Rr[i] = R; Cc[i] = C; const int Rb = Epi::PERM ? ((R & ~31) + perm32(R & 31)) : R;
        voB[i] = (unsigned)(Rb * g.ldb + C) * 2u;
#pragma unroll
        for (int h = 0; h < 2; ++h) { voA[h][i] = (unsigned)((R + HALF * h) * g.lda + C) * 2u; voAn[h][i] = voA[h][i]; } }
    const unsigned kstep = (unsigned)(BK * 2);
    const unsigned hstepB = (unsigned)HALF * g.ldb * 2u, hstepA = (unsigned)HALF * g.lda * 2u;
    const unsigned tstepA = 2u * hstepA, tstepB = 2u * hstepB;
    const __amdgpu_buffer_rsrc_t rA = __builtin_amdgcn_make_buffer_rsrc((void*)g.A, (short)0, 0x7fffffff, 0x00020000);
    const __amdgpu_buffer_rsrc_t rB = __builtin_amdgcn_make_buffer_rsrc((void*)g.Bt, (short)0, 0x7fffffff, 0x00020000);
    const int kmA = g.kmaskA;
    const unsigned ldsw = (unsigned)wid * 1024u;
    const int aoff = lds_byte(wr * 64 + fr, fq * 8), boff = lds_byte(wc * 32 + fr, fq * 8);
#define PG8_SA(b, h) (((b) * 2 + (h)) * HTB)
#define PG8_SB(b, h) ((4 + (b) * 2 + (h)) * HTB)
#define PG8_STAGE2(bufoff, rsrc, soff, o0, o1) do { \
        __builtin_amdgcn_raw_ptr_buffer_load_lds(rsrc, (LAS unsigned*)(lds + (bufoff) + ldsw), 16, (int)(o0), (int)(soff), 0, 0); \
        __builtin_amdgcn_raw_ptr_buffer_load_lds(rsrc, (LAS unsigned*)(lds + (bufoff) + ldsw + 8192), 16, (int)(o1), (int)(soff), 0, 0); } while (0)
#define PG8_STB(b, h, bo) PG8_STAGE2(PG8_SB(b, h), rB, (bo) + ((h) ? hstepB : 0u), voB[0], voB[1])
#define PG8_STA(b, h, ao, VO) do { if constexpr (GATHER) PG8_STAGE2(PG8_SA(b, h), rA, (ao), VO[h][0], VO[h][1]); else PG8_STAGE2(PG8_SA(b, h), rA, (ao) + ((h) ? hstepA : 0u), VO[0][0], VO[0][1]); } while (0)
#define PG8_STAX(b, h, ao) do { const unsigned _o0 = last ? voAn[h][0] : voA[h][0], _o1 = last ? voAn[h][1] : voA[h][1]; PG8_STAGE2(PG8_SA(b, h), rA, (ao), _o0, _o1); } while (0)
#define PG8_LDA(dst, b, h) do { _Pragma("unroll") for (int m = 0; m < 4; ++m) _Pragma("unroll") for (int k = 0; k < 2; ++k) dst[m][k] = *(const LAS bf16x8*)(lds + PG8_SA(b, h) + aoff + m * 2048 + k * 1024); } while (0)
#define PG8_LDB(dst, b, h) do { _Pragma("unroll") for (int n = 0; n < 2; ++n) _Pragma("unroll") for (int k = 0; k < 2; ++k) dst[n][k] = *(const LAS bf16x8*)(lds + PG8_SB(b, h) + boff + n * 2048 + k * 1024); } while (0)
#define PG8_MMA(ai, bj, At, Bt) do { __builtin_amdgcn_s_setprio(1); _Pragma("unroll") for (int m = 0; m < 4; ++m) _Pragma("unroll") for (int n = 0; n < 2; ++n) _Pragma("unroll") for (int k = 0; k < 2; ++k) \
        acc[ai][bj][m][n] = __builtin_amdgcn_mfma_f32_16x16x32_bf16(Bt[n][k], At[m][k], acc[ai][bj][m][n], 0, 0, 0); __builtin_amdgcn_s_setprio(0); } while (0)
#define PG8_WAIT_V(n) asm volatile("s_waitcnt vmcnt(" #n ")" ::: "memory")
#define PG8_WAIT_L(n) asm volatile("s_waitcnt lgkmcnt(0)" ::: "memory")
#define PG8_BAR __builtin_amdgcn_s_barrier()
#define PG8_SCHED __builtin_amdgcn_sched_barrier(0)
#define PG8_KA(tt) (cA + (unsigned)((((tt) * BK) & kmA)) * 2u)
#define PG8_GOFF(VO, pmx) do { _Pragma("unroll") for (int _h = 0; _h < 2; ++_h) _Pragma("unroll") for (int _i = 0; _i < 2; ++_i) \
        VO[_h][_i] = (unsigned)(g.perm[(pmx) * BM + HALF * _h + Rr[_i]] * g.lda + Cc[_i]) * 2u; } while (0)
    Unit cur, nxt; int ui = 0;
    if (!S.next(0, cur)) return;
    f32x4 acc[2][2][4][2];
#pragma unroll
    for (int a = 0; a < 2; ++a)
#pragma unroll
        for (int b = 0; b < 2; ++b)
#pragma unroll
            for (int m = 0; m < 4; ++m)
#pragma unroll
                for (int n = 0; n < 2; ++n) acc[a][b][m][n] = (f32x4){0.f, 0.f, 0.f, 0.f};
    bf16x8 At[4][2], B0[2][2], B1[2][2];
    if constexpr (GATHER) PG8_GOFF(voA, cur.pm);
    unsigned cA = GATHER ? 0u : (unsigned)cur.pm * tstepA, cB = (unsigned)cur.pb * tstepB;
    PG8_STB(0, 0, cB); PG8_STB(0, 1, cB); PG8_STA(0, 0, cA, voA); PG8_STA(0, 1, cA, voA);
    if (wr == 1) PG8_BAR;
    PG8_WAIT_V(2); PG8_BAR;
    PG8_STB(1, 0, cB + kstep); PG8_STA(1, 0, cA + kstep, voA); PG8_STB(1, 1, cB + kstep);
    PG8_WAIT_V(6); PG8_BAR;
    for (;;) {
        const bool has_next = S.next(ui + 1, nxt);
        if constexpr (GATHER) { if (has_next) PG8_GOFF(voAn, nxt.pm); }
        const unsigned nA = GATHER ? cA : (has_next ? (unsigned)nxt.pm * tstepA : cA), nB = has_next ? (unsigned)nxt.pb * tstepB : cB;
        for (int t = 0; t < nt; t += 2) {
            if constexpr (Epi::HAS_MID) { if (t == (nt >> 1)) E.mid(acc, cur, wr, wc); }
            const bool last = (t == nt - 2) && (GATHER ? has_next : true);
            const bool lastp = (t == nt - 2);
            const unsigned a1 = PG8_KA(t + 1);
            const unsigned a2 = lastp ? nA : PG8_KA(t + 2), b2 = lastp ? nB : cB + (unsigned)(t + 2) * kstep;
            const unsigned a3 = lastp ? nA + kstep : PG8_KA(t + 3), b3 = b2 + kstep;
            PG8_LDB(B0, 0, 0); PG8_LDB(B1, 0, 1); PG8_SCHED; PG8_LDA(At, 0, 0); PG8_STA(1, 1, a1, voA);
            PG8_WAIT_V(8); PG8_WAIT_L(0); PG8_BAR; PG8_MMA(0, 0, At, B0); PG8_MMA(0, 1, At, B1); PG8_BAR; PG8_SCHED;
            PG8_LDA(At, 0, 1); PG8_STB(0, 0, b2); PG8_STB(0, 1, b2);
            if constexpr (GATHER) PG8_STAX(0, 0, a2); else PG8_STA(0, 0, a2, voA);
            PG8_WAIT_V(8); PG8_WAIT_L(0); PG8_BAR; PG8_MMA(1, 0, At, B0); PG8_MMA(1, 1, At, B1); PG8_BAR; PG8_SCHED;
            PG8_LDB(B0, 1, 0); PG8_LDB(B1, 1, 1); PG8_SCHED; PG8_LDA(At, 1, 0);
            if constexpr (GATHER) PG8_STAX(0, 1, a2); else PG8_STA(0, 1, a2, voA);
            PG8_WAIT_V(8); PG8_WAIT_L(0); PG8_BAR; PG8_MMA(0, 0, At, B0); PG8_MMA(0, 1, At, B1); PG8_BAR; PG8_SCHED;
            PG8_LDA(At, 1, 1); PG8_STB(1, 0, b3); PG8_STB(1, 1, b3);
            if constexpr (GATHER) PG8_STAX(1, 0, a3); else PG8_STA(1, 0, a3, voA);
            PG8_WAIT_V(8); PG8_WAIT_L(0); PG8_BAR; PG8_MMA(1, 0, At, B0); PG8_MMA(1, 1, At, B1); PG8_BAR; PG8_SCHED;
        }
        if (wr == 0) PG8_BAR;
        E(acc, cur, wr, wc, fr, fq);
        if (!has_next) break;
#pragma unroll
        for (int a = 0; a < 2; ++a)
#pragma unroll
            for (int b = 0; b < 2; ++b)
#pragma unroll
                for (int m = 0; m < 4; ++m)
#pragma unroll
                    for (int n = 0; n < 2; ++n) acc[a][b][m][n] = (f32x4){0.f, 0.f, 0.f, 0.f};
        cur = nxt; cA = nA; cB = nB; ++ui;
        if constexpr (GATHER) {
#pragma unroll
            for (int h = 0; h < 2; ++h)
#pragma unroll
                for (int i = 0; i < 2; ++i) voA[h][i] = voAn[h][i]; }
        if (wr == 1) PG8_BAR;
    }
    PG8_WAIT_V(0);
    PG8_BAR;
#undef PG8_SA
#undef PG8_SB
#undef PG8_STAGE2
#undef PG8_STB
#undef PG8_STA
#undef PG8_STAX
#undef PG8_LDA
#undef PG8_LDB
#undef PG8_MMA
#undef PG8_WAIT_V
#undef PG8_WAIT_L
#undef PG8_BAR
#undef PG8_SCHED
#undef PG8_KA
#undef PG8_GOFF
}

typedef f32x4 Acc[2][2][4][2];
struct EpiInMain {
    static constexpr bool PERM = true, HAS_MID = false;
    bf16_t* P;
    __device__ __forceinline__ void operator()(const Acc& acc, const Unit& u, int wr, int wc, int, int) const {
        const int l2 = fresh_lane(), fr = l2 & 15, fq = l2 >> 4;
        const int row0 = u.pm * BM + wr * 64 + fr, col0 = u.pn * BM + wc * 32 + 8 * fq; const bool sg = u.pn >= 5 && u.pn < 13;
#pragma unroll
        for (int ai = 0; ai < 2; ++ai)
#pragma unroll
            for (int m = 0; m < 4; ++m) { bf16_t* rowp = P + (size_t)(row0 + ai * HALF + m * 16) * PM_LD + col0;
#pragma unroll
                for (int bj = 0; bj < 2; ++bj) { f32x4 v0 = acc[ai][bj][m][0], v1 = acc[ai][bj][m][1];
                    if (sg) {
#pragma unroll
                        for (int i = 0; i < 4; ++i) { v0[i] = sigmoidf_fast(v0[i]); v1[i] = sigmoidf_fast(v1[i]); } }
                    u32x4 o; o.x = pk2(v0[0], v0[1]); o.y = pk2(v0[2], v0[3]); o.z = pk2(v1[0], v1[1]); o.w = pk2(v1[2], v1[3]);
                    *(u32x4*)(rowp + bj * HALF) = o; } }
    }
};
struct EpiF32 {
    static constexpr bool PERM = false, HAS_MID = false;
    float* C; int ldc;
    __device__ __forceinline__ void operator()(const Acc& acc, const Unit& u, int wr, int wc, int, int) const {
        const int l2 = fresh_lane(), fr = l2 & 15, fq = l2 >> 4;
        const int row0 = u.pm * BM + wr * 64 + fr, col0 = u.pn * BM + wc * 32 + 4 * fq;
#pragma unroll
        for (int ai = 0; ai < 2; ++ai)
#pragma unroll
            for (int m = 0; m < 4; ++m) { float* rowp = C + (size_t)(row0 + ai * HALF + m * 16) * ldc + col0;
#pragma unroll
                for (int bj = 0; bj < 2; ++bj)
#pragma unroll
                    for (int n = 0; n < 2; ++n) *(f32x4*)(rowp + bj * HALF + n * 16) = acc[ai][bj][m][n]; }
    }
};
struct EpiGateA {
    static constexpr bool PERM = false, HAS_MID = false;
    float* T1; const bf16_t* P;
    __device__ __forceinline__ void operator()(const Acc& acc, const Unit& u, int wr, int wc, int, int) const {
        const int l2 = fresh_lane(), fr = l2 & 15, fq = l2 >> 4;
        const int row0 = u.pm * BM + wr * 64 + fr, col0 = u.pn * BM + wc * 32 + 4 * fq;
#pragma unroll
        for (int ai = 0; ai < 2; ++ai)
#pragma unroll
            for (int m = 0; m < 4; ++m) { const size_t row = (size_t)(row0 + ai * HALF + m * 16);
#pragma unroll
                for (int bj = 0; bj < 2; ++bj)
#pragma unroll
                    for (int n = 0; n < 2; ++n) { const int c = col0 + bj * HALF + n * 16;
                        const u32x2 gp = *(const u32x2*)(P + row * PM_LD + PC_GA + c);
                        f32x4 v = acc[ai][bj][m][n];
                        v[0] *= bf2f(gp.x & 0xffffu); v[1] *= bf2f(gp.x >> 16); v[2] *= bf2f(gp.y & 0xffffu); v[3] *= bf2f(gp.y >> 16);
                        *(f32x4*)(T1 + row * 1024 + c) = v; }
                asm volatile("" ::: "memory"); }
    }
};
struct EpiGateB {
    static constexpr bool PERM = true, HAS_MID = false;
    bf16_t* MG; const float* T1; const bf16_t* P;
    __device__ __forceinline__ void operator()(const Acc& acc, const Unit& u, int wr, int wc, int, int) const {
        const int l2 = fresh_lane(), fr = l2 & 15, fq = l2 >> 4;
        const int row0 = u.pm * BM + wr * 64 + fr, col0 = u.pn * BM + wc * 32 + 8 * fq;
#pragma unroll
        for (int ai = 0; ai < 2; ++ai)
#pragma unroll
            for (int m = 0; m < 4; ++m) { const size_t row = (size_t)(row0 + ai * HALF + m * 16);
#pragma unroll
                for (int bj = 0; bj < 2; ++bj) { const int c = col0 + bj * HALF;
                    const u32x4 gp = *(const u32x4*)(P + row * PM_LD + PC_GB + c);
                    const f32x4 t0 = *(const f32x4*)(T1 + row * 1024 + c), t1 = *(const f32x4*)(T1 + row * 1024 + c + 4);
                    const f32x4 a0 = acc[ai][bj][m][0], a1 = acc[ai][bj][m][1];
                    u32x4 o;
                    o.x = pk2(t0[0] + bf2f(gp.x & 0xffffu) * a0[0], t0[1] + bf2f(gp.x >> 16) * a0[1]);
                    o.y = pk2(t0[2] + bf2f(gp.y & 0xffffu) * a0[2], t0[3] + bf2f(gp.y >> 16) * a0[3]);
                    o.z = pk2(t1[0] + bf2f(gp.z & 0xffffu) * a1[0], t1[1] + bf2f(gp.z >> 16) * a1[1]);
                    o.w = pk2(t1[2] + bf2f(gp.w & 0xffffu) * a1[2], t1[3] + bf2f(gp.w >> 16) * a1[3]);
                    *(u32x4*)(MG + row * 1024 + c) = o; }
                asm volatile("" ::: "memory"); }
    }
};
struct EpiGate {
    static constexpr bool PERM = true, HAS_MID = true;
    bf16_t* MG; const bf16_t* P;
    __device__ __forceinline__ void mid(Acc& acc, const Unit& u, int wr, int wc) const {
        const int l2 = fresh_lane(), fr = l2 & 15, fq = l2 >> 4;
        const int row0 = u.pm * BM + wr * 64 + fr, col0 = u.pn * BM + wc * 32 + 8 * fq;
#pragma unroll
        for (int ai = 0; ai < 2; ++ai) {
            u32x4 ga[4][2], gb[4][2];
#pragma unroll
            for (int m = 0; m < 4; ++m)
#pragma unroll
                for (int bj = 0; bj < 2; ++bj) { const bf16_t* gp = P + (size_t)(row0 + ai * HALF + m * 16) * PM_LD + col0 + bj * HALF;
                    ga[m][bj] = *(const u32x4*)(gp + PC_GA); gb[m][bj] = *(const u32x4*)(gp + PC_GB); }
#pragma unroll
            for (int m = 0; m < 4; ++m)
#pragma unroll
                for (int bj = 0; bj < 2; ++bj) { const u32x4 a = ga[m][bj], g = gb[m][bj];
                    f32x4& a0 = acc[ai][bj][m][0]; f32x4& a1 = acc[ai][bj][m][1];
                    a0[0] *= bf2f(a.x & 0xffffu) * __builtin_amdgcn_rcpf(bf2f(g.x & 0xffffu)); a0[1] *= bf2f(a.x >> 16) * __builtin_amdgcn_rcpf(bf2f(g.x >> 16));
                    a0[2] *= bf2f(a.y & 0xffffu) * __builtin_amdgcn_rcpf(bf2f(g.y & 0xffffu)); a0[3] *= bf2f(a.y >> 16) * __builtin_amdgcn_rcpf(bf2f(g.y >> 16));
                    a1[0] *= bf2f(a.z & 0xffffu) * __builtin_amdgcn_rcpf(bf2f(g.z & 0xffffu)); a1[1] *= bf2f(a.z >> 16) * __builtin_amdgcn_rcpf(bf2f(g.z >> 16));
                    a1[2] *= bf2f(a.w & 0xffffu) * __builtin_amdgcn_rcpf(bf2f(g.w & 0xffffu)); a1[3] *= bf2f(a.w >> 16) * __builtin_amdgcn_rcpf(bf2f(g.w >> 16)); }
            asm volatile("" ::: "memory"); }
    }
    __device__ __forceinline__ void operator()(const Acc& acc, const Unit& u, int wr, int wc, int, int) const {
        const int l2 = fresh_lane(), fr = l2 & 15, fq = l2 >> 4;
        const int row0 = u.pm * BM + wr * 64 + fr, col0 = u.pn * BM + wc * 32 + 8 * fq;
#pragma unroll
        for (int ai = 0; ai < 2; ++ai) {
            u32x4 gb[4][2];
#pragma unroll
            for (int m = 0; m < 4; ++m)
#pragma unroll
                for (int bj = 0; bj < 2; ++bj) gb[m][bj] = *(const u32x4*)(P + (size_t)(row0 + ai * HALF + m * 16) * PM_LD + PC_GB + col0 + bj * HALF);
#pragma unroll
            for (int m = 0; m < 4; ++m)
#pragma unroll
                for (int bj = 0; bj < 2; ++bj) { const u32x4 g = gb[m][bj];
                    const f32x4 a0 = acc[ai][bj][m][0], a1 = acc[ai][bj][m][1];
                    u32x4 o;
                    o.x = pk2(bf2f(g.x & 0xffffu) * a0[0], bf2f(g.x >> 16) * a0[1]); o.y = pk2(bf2f(g.y & 0xffffu) * a0[2], bf2f(g.y >> 16) * a0[3]);
                    o.z = pk2(bf2f(g.z & 0xffffu) * a1[0], bf2f(g.z >> 16) * a1[1]); o.w = pk2(bf2f(g.w & 0xffffu) * a1[2], bf2f(g.w >> 16) * a1[3]);
                    *(u32x4*)(MG + (size_t)(row0 + ai * HALF + m * 16) * 1024 + col0 + bj * HALF) = o; }
            asm volatile("" ::: "memory"); }
    }
};
template <bool XA_BF16> struct EpiWout {
    static constexpr bool PERM = true, HAS_MID = false;
    bf16_t* X1; const void* XA; const float* g1;
    __device__ __forceinline__ void operator()(const Acc& acc, const Unit& u, int wr, int wc, int, int) const {
        const int l2 = fresh_lane(), fr = l2 & 15, fq = l2 >> 4;
        const int row0 = u.pm * BM + wr * 64 + fr, col0 = u.pn * BM + wc * 32 + 8 * fq;
        const float* gb = g1 + (size_t)((u.pm * BM) / SEQ) * 6144;
#pragma unroll
        for (int bj = 0; bj < 2; ++bj) { const int c = col0 + bj * HALF;
            const f32x4 g0 = *(const f32x4*)(gb + c), g1v = *(const f32x4*)(gb + c + 4);
#pragma unroll
            for (int ai = 0; ai < 2; ++ai)
#pragma unroll
                for (int m = 0; m < 4; ++m) { const size_t row = (size_t)(row0 + ai * HALF + m * 16);
                    f32x4 x0, x1;
                    if constexpr (XA_BF16) { const u32x4 xb = *(const u32x4*)((const bf16_t*)XA + row * 1024 + c);
                        x0 = (f32x4){bf2f(xb.x & 0xffffu), bf2f(xb.x >> 16), bf2f(xb.y & 0xffffu), bf2f(xb.y >> 16)}; x1 = (f32x4){bf2f(xb.z & 0xffffu), bf2f(xb.z >> 16), bf2f(xb.w & 0xffffu), bf2f(xb.w >> 16)}; }
                    else { x0 = *(const f32x4*)((const float*)XA + row * 1024 + c); x1 = *(const f32x4*)((const float*)XA + row * 1024 + c + 4); }
                    const f32x4 v0 = x0 + g0 * acc[ai][bj][m][0], v1 = x1 + g1v * acc[ai][bj][m][1];
                    u32x4 o; o.x = pk2(v0[0], v0[1]); o.y = pk2(v0[2], v0[3]); o.z = pk2(v1[0], v1[1]); o.w = pk2(v1[2], v1[3]);
                    *(u32x4*)(X1 + row * 1024 + c) = o; }
            asm volatile("" ::: "memory"); }
    }
};
struct EpiGU {
    static constexpr bool PERM = true, HAS_MID = false;
    bf16_t* ACT; const float* bgu;
    __device__ __forceinline__ void operator()(const Acc& acc, const Unit& u, int wr, int wc, int, int) const {
        const int l2 = fresh_lane(), fr = l2 & 15, fq = l2 >> 4;
        const int row0 = u.pm * BM + wr * 64 + fr, cl = wc * 32 + 8 * fq, e = u.pb >> 2;
        const float* bg = bgu + (size_t)e * 1024 + u.pn * 128 + cl;
        const f32x4 bg0 = *(const f32x4*)bg, bg1 = *(const f32x4*)(bg + 4), bu0 = *(const f32x4*)(bg + 512), bu1 = *(const f32x4*)(bg + 516);
#pragma unroll
        for (int ai = 0; ai < 2; ++ai)
#pragma unroll
            for (int m = 0; m < 4; ++m) { const size_t row = (size_t)(row0 + ai * HALF + m * 16);
                float r[8];
#pragma unroll
                for (int i = 0; i < 4; ++i) {
                    float g0 = acc[ai][0][m][0][i] + bg0[i], u0 = acc[ai][1][m][0][i] + bu0[i];
                    float g1 = acc[ai][0][m][1][i] + bg1[i], u1 = acc[ai][1][m][1][i] + bu1[i];
                    g0 = fminf(g0, 7.f); u0 = fminf(fmaxf(u0, -7.f), 7.f); g1 = fminf(g1, 7.f); u1 = fminf(fmaxf(u1, -7.f), 7.f);
                    r[i] = g0 * sigmoidf_fast(1.702f * g0) * (u0 + 1.f); r[4 + i] = g1 * sigmoidf_fast(1.702f * g1) * (u1 + 1.f); }
                u32x4 o; o.x = pk2(r[0], r[1]); o.y = pk2(r[2], r[3]); o.z = pk2(r[4], r[5]); o.w = pk2(r[6], r[7]);
                *(u32x4*)(ACT + row * 512 + u.pn * 128 + cl) = o; }
    }
};
struct EpiDown {
    static constexpr bool PERM = true, HAS_MID = false;
    bf16_t* YS; const float* bdn;
    __device__ __forceinline__ void operator()(const Acc& acc, const Unit& u, int wr, int wc, int, int) const {
        const int l2 = fresh_lane(), fr = l2 & 15, fq = l2 >> 4;
        const int row0 = u.pm * BM + wr * 64 + fr, col0 = u.pn * BM + wc * 32 + 8 * fq, e = u.pb >> 2;
        const float* bp = bdn + (size_t)e * 1024 + col0;
#pragma unroll
        for (int bj = 0; bj < 2; ++bj) {
            const f32x4 b0 = *(const f32x4*)(bp + bj * HALF), b1 = *(const f32x4*)(bp + bj * HALF + 4);
#pragma unroll
            for (int ai = 0; ai < 2; ++ai)
#pragma unroll
                for (int m = 0; m < 4; ++m) { bf16_t* rowp = YS + (size_t)(row0 + ai * HALF + m * 16) * 1024 + col0 + bj * HALF;
                    const f32x4 v0 = acc[ai][bj][m][0] + b0, v1 = acc[ai][bj][m][1] + b1;
                    u32x4 o; o.x = pk2(v0[0], v0[1]); o.y = pk2(v0[2], v0[3]); o.z = pk2(v1[0], v1[1]); o.w = pk2(v1[2], v1[3]);
                    *(u32x4*)rowp = o; }
            asm volatile("" ::: "memory"); }
    }
};
}

struct Args { const float* in[22]; float* out; unsigned char* ws; int ph_lo, ph_hi, use_bar, pad; };
struct Frame {
    LAS unsigned char* lds; volatile LAS unsigned* MISC;
    int wave, vcu, G, gw, NGW;
    GAS unsigned char* ws; GAS unsigned* ctl;
};
enum { I_X = 0, I_C, I_N1G, I_N2G, I_WADA, I_BADA, I_WIN, I_KVG, I_WUK, I_WUV, I_WPOOL, I_PSCALE, I_WAUP, I_WBUP, I_WOUT, I_WR, I_BR, I_WGU, I_BGU, I_WDN, I_BDN, I_FG };

struct TJob { const float* src; int ld_src, scol0, nvalid, nwrite, K; bf16_t* dst; int ld_dst, drow0, mode; };
__device__ __forceinline__ void tr_tile(const TJob& J, int k0, int n0, LAS float* scr, int lane) {
    if (n0 + 64 <= J.nvalid) {
#pragma unroll 8
        for (int i = 0; i < 16; ++i) {
            const int kk = 4 * i + (lane >> 4), nc = (lane & 15) * 4;
            const f32x4 v = *(const f32x4*)(J.src + (size_t)(k0 + kk) * J.ld_src + J.scol0 + n0 + nc);
            scr[kk * 65 + nc + 0] = v[0]; scr[kk * 65 + nc + 1] = v[1]; scr[kk * 65 + nc + 2] = v[2]; scr[kk * 65 + nc + 3] = v[3];
        }
    } else {
#pragma unroll 4
        for (int i = 0; i < 16; ++i) {
            const int kk = 4 * i + (lane >> 4), nc = (lane & 15) * 4;
            f32x4 v = (f32x4){0.f, 0.f, 0.f, 0.f};
            if (n0 + nc < J.nvalid) v = *(const f32x4*)(J.src + (size_t)(k0 + kk) * J.ld_src + J.scol0 + n0 + nc);
            scr[kk * 65 + nc + 0] = v[0]; scr[kk * 65 + nc + 1] = v[1]; scr[kk * 65 + nc + 2] = v[2]; scr[kk * 65 + nc + 3] = v[3];
        }
    }
    asm volatile("s_waitcnt lgkmcnt(0)" ::: "memory");
    const int c = lane & 7;
#pragma unroll
    for (int j = 0; j < 8; ++j) {
        const int n = j * 8 + (lane >> 3);
        float v[8];
#pragma unroll
        for (int q = 0; q < 8; ++q) v[q] = scr[(8 * c + q) * 65 + n];
        if (n0 + n < J.nwrite) {
            bf16_t* d = J.dst + (size_t)(J.drow0 + n0 + n) * J.ld_dst + k0 + 8 * c;
            u32x4 hi; hi.x = pk2(v[0], v[1]); hi.y = pk2(v[2], v[3]); hi.z = pk2(v[4], v[5]); hi.w = pk2(v[6], v[7]);
            *(u32x4*)d = hi;
            if (J.mode == 2) {
                float r[8];
#pragma unroll
                for (int q = 0; q < 8; ++q) r[q] = v[q] - bf2f(f2bf(v[q]));
                u32x4 lo; lo.x = pk2(r[0], r[1]); lo.y = pk2(r[2], r[3]); lo.z = pk2(r[4], r[5]); lo.w = pk2(r[6], r[7]);
                *(u32x4*)(d + 1024) = hi; *(u32x4*)(d + 2048) = lo;
            }
        }
    }
    asm volatile("s_waitcnt lgkmcnt(0)" ::: "memory");
}
constexpr int TJ_ITEMS_LAYER = 128 + 128 + 64 + 256 + 256 + 32 + 16 + 32 + 128 + 128 + 256 + 64 + 16 + 16 + 8192 + 4096;
__device__ __forceinline__ void tj_decode(const Args& a, int it, TJob& J, int& k0, int& n0) {
    const int l = it / TJ_ITEMS_LAYER; int r = it % TJ_ITEMS_LAYER;
    unsigned char* wl = a.ws + WS_W + (size_t)l * WL_BYTES;
    const float* win = a.in[I_WIN] + (size_t)l * DM * IN_W;
    int ntn;
#define TJ_SET(SRC, LDS_, SC0, NV, NW, KK, DST, LDD, DR0, MD) { J.src = (SRC); J.ld_src = (LDS_); J.scol0 = (SC0); J.nvalid = (NV); J.nwrite = (NW); J.K = (KK); J.dst = (bf16_t*)(DST); J.ld_dst = (LDD); J.drow0 = (DR0); J.mode = (MD); ntn = ((NW) + 63) / 64; }
    if (r < 128) TJ_SET(win, IN_W, SC_Q, 512, 512, 1024, wl + WO_INMAIN, 1024, PC_Q, 0)
    else if ((r -= 128) < 128) TJ_SET(win, IN_W, SC_POOL, 512, 512, 1024, wl + WO_INMAIN, 1024, PC_POOL, 0)
    else if ((r -= 128) < 64) TJ_SET(win, IN_W, SC_CKV, 128, 256, 1024, wl + WO_INMAIN, 1024, PC_CKV, 0)
    else if ((r -= 64) < 256) TJ_SET(win, IN_W, SC_GA, 1024, 1024, 1024, wl + WO_INMAIN, 1024, PC_GA, 0)
    else if ((r -= 256) < 256) TJ_SET(win, IN_W, SC_GB, 1024, 1024, 1024, wl + WO_INMAIN, 1024, PC_GB, 0)
    else if ((r -= 256) < 32) TJ_SET(win, IN_W, SC_QI, 128, 128, 1024, wl + WO_INMAIN, 1024, PC_QI, 0)
    else if ((r -= 32) < 16) TJ_SET(win, IN_W, SC_KI, 32, 32, 1024, wl + WO_INMAIN, 1024, PC_KI, 0)
    else if ((r -= 16) < 32) TJ_SET(win, IN_W, SC_WI, 4, 96, 1024, wl + WO_INMAIN, 1024, PC_WI, 0)
    else if ((r -= 32) < 128) TJ_SET(a.in[I_WAUP] + (size_t)l * 512 * 1024, 1024, 0, 1024, 1024, 512, wl + WO_WA, 1024, 0, 0)
    else if ((r -= 128) < 128) TJ_SET(a.in[I_WBUP] + (size_t)l * 512 * 1024, 1024, 0, 1024, 1024, 512, wl + WO_WA + 1024, 1024, 0, 0)
    else if ((r -= 128) < 256) TJ_SET(a.in[I_WOUT] + (size_t)l * 1024 * 1024, 1024, 0, 1024, 1024, 1024, wl + WO_WOUT, 1024, 0, 0)
    else if ((r -= 256) < 64) TJ_SET(a.in[I_WR] + (size_t)l * 1024 * 32, 32, 0, 32, 256, 1024, wl + WO_WRP, 3072, 0, 2)
    else if ((r -= 64) < 16) TJ_SET(a.in[I_WUV] + (size_t)l * 128 * 512, 512, 0, 512, 512, 128, wl + WO_WUV, 128, 0, 0)
    else if ((r -= 16) < 16) { const int g = r >> 2; r &= 3; TJ_SET(a.in[I_WPOOL] + ((size_t)l * 4 + g) * 128 * 128, 128, 0, 128, 128, 128, wl + WO_WPOOL + (size_t)g * 128 * 128 * 2, 128, 0, 0) }
    else if ((r -= 16) < 8192) { const int e = r >> 8, j = (r >> 5) & 7, pn = j >> 1, half = j & 1; r &= 31;
        TJ_SET(a.in[I_WGU] + ((size_t)l * 32 + e) * 1024 * 1024, 1024, half * 512 + pn * 128, 128, 128, 1024, wl + WO_WGU + (size_t)e * 1024 * 1024 * 2, 1024, pn * 256 + half * 128, 0) }
    else { r -= 8192; const int e = r >> 7; r &= 127;
        TJ_SET(a.in[I_WDN] + ((size_t)l * 32 + e) * 512 * 1024, 1024, 0, 1024, 1024, 512, wl + WO_WDN + (size_t)e * 1024 * 512 * 2, 512, 0, 0) }
#undef TJ_SET
    k0 = (r / ntn) * 64; n0 = (r % ntn) * 64;
}
__device__ __forceinline__ void phase_prologue(const Args& a, Frame& F) {
    const int plane = fresh_lane(), ptid = F.wave * 64 + plane;
    {
        LAS float* cond = (LAS float*)F.lds;
        LAS float* red = (LAS float*)(F.lds + 32768);
        for (int i = ptid; i < 8 * 1024; i += NTHREADS) { const float c = a.in[I_C][i]; cond[i] = c / (1.f + __expf(-c)); }
        __syncthreads();
        const int cs = ptid & 63, ks = ptid >> 6;
        for (int it = F.vcu; it < DEPTH * 96; it += F.G) {
            const int l = it / 96, col = (it % 96) * 64 + cs;
            const float* w = a.in[I_WADA] + (size_t)l * 1024 * 6144 + (size_t)(ks * 128) * 6144 + col;
            float acc[8] = {0, 0, 0, 0, 0, 0, 0, 0};
#pragma unroll 32
            for (int k = 0; k < 128; ++k) { const float wv = w[(size_t)k * 6144];
#pragma unroll
                for (int b = 0; b < 8; ++b) acc[b] += cond[b * 1024 + ks * 128 + k] * wv; }
#pragma unroll
            for (int b = 0; b < 8; ++b) red[(ks * 8 + b) * 64 + cs] = acc[b];
            __syncthreads();
            { const int b = ptid >> 6; float s = 0.f;
#pragma unroll
              for (int k2 = 0; k2 < 8; ++k2) s += red[(k2 * 8 + b) * 64 + cs];
              ((float*)(a.ws + WS_ADA))[((size_t)l * 8 + b) * 6144 + col] = s + a.in[I_BADA][(size_t)l * 6144 + col]; }
            __syncthreads();
        }
    }
    {
        LAS float* scr = (LAS float*)(F.lds + F.wave * 16640);
        for (int it = F.gw; it < DEPTH * TJ_ITEMS_LAYER; it += F.NGW) {
            TJob J; int k0, n0; tj_decode(a, it, J, k0, n0);
            tr_tile(J, k0, n0, scr, plane);
        }
        for (int i = F.gw * 64 + plane; i < DEPTH * 128 * 512 / 4; i += F.NGW * 64) {
            const int l = i / (128 * 128), r = i % (128 * 128), lat = r / 128, hd = (r % 128) * 4, h = hd >> 6, d = hd & 63;
            const f32x4 v = *(const f32x4*)(a.in[I_WUK] + (size_t)l * 128 * 512 + lat * 512 + hd);
            u32x2 o; o.x = pk2(v[0], v[1]); o.y = pk2(v[2], v[3]);
            *(u32x2*)((bf16_t*)(a.ws + WS_W + (size_t)l * WL_BYTES + WO_WUK) + (h * 128 + lat) * 64 + d) = o;
        }
    }
}

__device__ __forceinline__ void store_hilo(bf16_t* hc_row, int lane, const f32x4 (&h)[4]) {
#pragma unroll
    for (int j = 0; j < 4; ++j) {
        const unsigned h0 = f2bf(h[j][0]), h1 = f2bf(h[j][1]), h2 = f2bf(h[j][2]), h3 = f2bf(h[j][3]);
        u32x2 hi; hi.x = h0 | (h1 << 16); hi.y = h2 | (h3 << 16);
        *(u32x2*)(hc_row + 4 * lane + 256 * j) = hi;
    }
}
__device__ __forceinline__ void norm_mod_row(const f32x4 (&v)[4], int lane, const float* gam, const float* sc, const float* sh, bf16_t* hc_row) {
    float ss = 0.f;
#pragma unroll
    for (int j = 0; j < 4; ++j) ss += (v[j][0] * v[j][0] + v[j][1] * v[j][1]) + (v[j][2] * v[j][2] + v[j][3] * v[j][3]);
    const float rstd = 1.0f / sqrtf(wave_sum(ss) * (1.f / DM) + RMS_EPS);
    f32x4 h[4];
#pragma unroll
    for (int j = 0; j < 4; ++j) { const int c = 4 * lane + 256 * j;
        const f32x4 g = *(const f32x4*)(gam + c), s1 = *(const f32x4*)(sc + c), s0 = *(const f32x4*)(sh + c);
        h[j] = (v[j] * rstd * g) * (s1 + 1.f) + s0; }
    store_hilo(hc_row, lane, h);
}
__device__ __forceinline__ void phase_norm(Frame& F, const float* X, const float* gam, const float* ada_l, int off_sh, int off_sc) {
    bf16_t* HC = (bf16_t*)(F.ws + WS_HC);
    const int lane = fresh_lane();
    for (int row = F.gw; row < NTOK; row += F.NGW) {
        const f32x4* xr = (const f32x4*)(X + (size_t)row * DM) + lane;
        f32x4 v[4];
#pragma unroll
        for (int j = 0; j < 4; ++j) v[j] = xr[64 * j];
        const float* ab = ada_l + (size_t)(row / SEQ) * 6144;
        norm_mod_row(v, lane, gam, ab + off_sc, ab + off_sh, HC + (size_t)row * 1024);
    }
}

template <int G>
__device__ __forceinline__ void pool_group(const bf16_t* P, const bf16_t* WP, const float* pscale, bf16_t* OAB, int tile, int fr, int fq) {
    constexpr int W = 2 << G;
    const int tok = tile * 16 + fr, t = tok % SEQ;
    const int nwin = (t + 1 < W) ? t + 1 : W;
    const float inv = 1.f / (float)nwin;
    bf16x8 Af[4];
#pragma unroll
    for (int kk = 0; kk < 4; ++kk) {
        const bf16_t* base = P + (size_t)tok * PM_LD + PC_POOL + G * 128 + 32 * kk + 8 * fq;
        u32x4 pv[W];
#pragma unroll
        for (int d = 0; d < W; ++d) pv[d] = *(const u32x4*)(base - (size_t)((d < nwin) ? d : 0) * PM_LD);
        float s[8] = {0, 0, 0, 0, 0, 0, 0, 0};
#pragma unroll
        for (int d = 0; d < W; ++d) { const float mk = (d < nwin) ? 1.f : 0.f;
            s[0] += mk * bf2f(pv[d].x & 0xffffu); s[1] += mk * bf2f(pv[d].x >> 16); s[2] += mk * bf2f(pv[d].y & 0xffffu); s[3] += mk * bf2f(pv[d].y >> 16);
            s[4] += mk * bf2f(pv[d].z & 0xffffu); s[5] += mk * bf2f(pv[d].z >> 16); s[6] += mk * bf2f(pv[d].w & 0xffffu); s[7] += mk * bf2f(pv[d].w >> 16); }
        const u32x4 sv = pv[0];
        u32x4 o; o.x = pk2(s[0] * inv - bf2f(sv.x & 0xffffu), s[1] * inv - bf2f(sv.x >> 16)); o.y = pk2(s[2] * inv - bf2f(sv.y & 0xffffu), s[3] * inv - bf2f(sv.y >> 16));
        o.z = pk2(s[4] * inv - bf2f(sv.z & 0xffffu), s[5] * inv - bf2f(sv.z >> 16)); o.w = pk2(s[6] * inv - bf2f(sv.w & 0xffffu), s[7] * inv - bf2f(sv.w >> 16));
        Af[kk] = __builtin_bit_cast(bf16x8, o);
    }
#pragma unroll 1
    for (int nh = 0; nh < 2; ++nh) {
        bf16x8 Bf[4][4];
#pragma unroll
        for (int n4 = 0; n4 < 4; ++n4)
#pragma unroll
            for (int kk = 0; kk < 4; ++kk) Bf[n4][kk] = *(const bf16x8*)(WP + ((size_t)G * 128 + (nh * 4 + n4) * 16 + fr) * 128 + 32 * kk + 8 * fq);
#pragma unroll
        for (int n4 = 0; n4 < 4; ++n4) { const int nt = nh * 4 + n4;
            f32x4 c = (f32x4){0.f, 0.f, 0.f, 0.f};
#pragma unroll
            for (int kk = 0; kk < 4; ++kk) c = __builtin_amdgcn_mfma_f32_16x16x32_bf16(Bf[n4][kk], Af[kk], c, 0, 0, 0);
            const int dcol = G * 128 + nt * 16 + 4 * fq; const f32x4 ps = *(const f32x4*)(pscale + dcol);
            u32x2 w2; w2.x = pk2(c[0] * ps[0], c[1] * ps[1]); w2.y = pk2(c[2] * ps[2], c[3] * ps[3]);
            *(u32x2*)(OAB + (size_t)(tile * 16 + fr) * 1024 + 512 + dcol) = w2;
        }
    }
}
__device__ __forceinline__ void phase_prep(const Args& a, Frame& F, int l) {
    const bf16_t* P = (const bf16_t*)(F.ws + WS_P);
    bf16_t* CKVN = (bf16_t*)(F.ws + WS_CKVN); bf16_t* KI = (bf16_t*)(F.ws + WS_KIH);
    const float* kvg = a.in[I_KVG] + (size_t)l * 128;
    const int lane = fresh_lane(), fr = lane & 15, fq = lane >> 4;
    { f32x4 kg0 = *(const f32x4*)(kvg + 8 * fr), kg1 = *(const f32x4*)(kvg + 8 * fr + 4);
      for (int r4 = F.gw; r4 < NTOK / 4; r4 += F.NGW) {
        const size_t row = (size_t)r4 * 4 + fq;
        const u32x4 cp = *(const u32x4*)(P + row * PM_LD + PC_CKV + 8 * fr);
        float c[8] = {bf2f(cp.x & 0xffffu), bf2f(cp.x >> 16), bf2f(cp.y & 0xffffu), bf2f(cp.y >> 16), bf2f(cp.z & 0xffffu), bf2f(cp.z >> 16), bf2f(cp.w & 0xffffu), bf2f(cp.w >> 16)};
        float ss = (c[0] * c[0] + c[1] * c[1]) + (c[2] * c[2] + c[3] * c[3]) + (c[4] * c[4] + c[5] * c[5]) + (c[6] * c[6] + c[7] * c[7]);
        ss += dpp_f(ss, 0); ss += dpp_f(ss, 1); ss += dpp_f(ss, 2); ss += dpp_f(ss, 3);
        const float rstd = 1.0f / sqrtf(ss * (1.f / 128.f) + RMS_EPS);
        u32x4 o; o.x = pk2(c[0] * rstd * kg0[0], c[1] * rstd * kg0[1]); o.y = pk2(c[2] * rstd * kg0[2], c[3] * rstd * kg0[3]);
        o.z = pk2(c[4] * rstd * kg1[0], c[5] * rstd * kg1[1]); o.w = pk2(c[6] * rstd * kg1[2], c[7] * rstd * kg1[3]);
        *(u32x4*)(CKVN + row * 128 + 8 * fr) = o;
        if (fr < 4) *(u32x4*)(KI + row * 32 + 8 * fr) = *(const u32x4*)(P + row * PM_LD + PC_KI + 8 * fr);
      } }
    bf16_t* OAB = (bf16_t*)(F.ws + WS_OAB);
    const bf16_t* WP = (const bf16_t*)(F.ws + WS_W + (size_t)l * WL_BYTES + WO_WPOOL);
    const float* pscale = a.in[I_PSCALE] + (size_t)l * 512;
    for (int tile = F.gw; tile < NTOK / 16; tile += F.NGW) {
        pool_group<0>(P, WP, pscale, OAB, tile, fr, fq);
        pool_group<1>(P, WP, pscale, OAB, tile, fr, fq);
        pool_group<2>(P, WP, pscale, OAB, tile, fr, fq);
        pool_group<3>(P, WP, pscale, OAB, tile, fr, fq);
    }
}

__device__ __forceinline__ unsigned gimg_off(int row, int ch) { return 256u * row + 16u * (ch ^ (((row & 3) << 2) | ((row >> 2) & 3))); }
__device__ __forceinline__ s16x4 lds_tr16(LAS unsigned char* p) { typedef short v4s __attribute__((ext_vector_type(4))); return __builtin_bit_cast(s16x4, __builtin_amdgcn_ds_read_tr16_b64_v4i16((LAS v4s*)p)); }

__device__ __forceinline__ void phase_attention(const Args& a, Frame& F, int l) {
    const bf16_t* P = (const bf16_t*)(F.ws + WS_P);
    const float* IDXP = (const float*)(F.ws + WS_IDXP);
    const bf16_t* CKVN = (const bf16_t*)(F.ws + WS_CKVN); const bf16_t* KIH = (const bf16_t*)(F.ws + WS_KIH); const bf16_t* KIL = (const bf16_t*)(F.ws + WS_KIL);
    bf16_t* OAB = (bf16_t*)(F.ws + WS_OAB);
    const bf16_t* WUK = (const bf16_t*)(F.ws + WS_W + (size_t)l * WL_BYTES + WO_WUK);
    const bf16_t* WUV = (const bf16_t*)(F.ws + WS_W + (size_t)l * WL_BYTES + WO_WUV);
    const int lane = fresh_lane();
    const int wave = F.wave, fr = lane & 15, fq = lane >> 4;
    constexpr int SCROW = 4112;
    LAS float* SC = (LAS float*)F.lds;
    LAS unsigned char* myreg = F.lds + wave * (SCROW * 4);
    LAS unsigned short* IDXL0 = (LAS unsigned short*)(F.lds + IDXL_OFF) + wave * 256;
    LAS unsigned short* IDXL1 = (LAS unsigned short*)(F.lds + QL_OFF + 1024) + wave * 256;
    bf16_t* QLG = (bf16_t*)(F.ws + WS_XS) + (size_t)F.vcu * 128 * 1024;
    bf16_t* OLG = (bf16_t*)(F.ws + WS_XS + 64 * MiB) + (size_t)F.vcu * 128 * 1024;
#define TOK_OF(qi) ((size_t)((qi) >> 4) * SEQ + (size_t)((((qi) >> 3) & 1) ? (511 - F.vcu) : F.vcu) * 8 + ((qi) & 7))
    {
        const int h = wave;
        bf16x8 Bk[8][2];
#pragma unroll
        for (int nt = 0; nt < 8; ++nt)
#pragma unroll
            for (int kk = 0; kk < 2; ++kk) Bk[nt][kk] = *(const bf16x8*)(WUK + ((size_t)h * 128 + nt * 16 + fr) * 64 + 32 * kk + 8 * fq);
#pragma unroll 1
        for (int mt = 0; mt < 8; ++mt) {
            const int qi = 16 * mt + fr;
            const bf16_t* qp = P + TOK_OF(qi) * PM_LD + PC_Q + h * 64 + 8 * fq;
            const bf16x8 Aq0 = *(const bf16x8*)qp, Aq1 = *(const bf16x8*)(qp + 32);
#pragma unroll
            for (int nt = 0; nt < 8; ++nt) {
                f32x4 c = (f32x4){0.f, 0.f, 0.f, 0.f};
                c = __builtin_amdgcn_mfma_f32_16x16x32_bf16(Bk[nt][0], Aq0, c, 0, 0, 0);
                c = __builtin_amdgcn_mfma_f32_16x16x32_bf16(Bk[nt][1], Aq1, c, 0, 0, 0);
                u32x2 w2; w2.x = pk2(c[0] * (0.125f * LOG2E), c[1] * (0.125f * LOG2E)); w2.y = pk2(c[2] * (0.125f * LOG2E), c[3] * (0.125f * LOG2E));
                *(u32x2*)(QLG + ((size_t)qi * 8 + h) * 128 + 16 * nt + 4 * fq) = w2;
            }
        }
        asm volatile("s_waitcnt vmcnt(0)" ::: "memory");
    }
    __syncthreads();
#define UNIT_PARAMS(half) const int ui = 2 * b + (half); const int pb = (half) ? (511 - F.vcu) : F.vcu; \
        const int t0 = pb * 8;                             \
        const size_t tok0 = (size_t)b * SEQ + t0; \
        const bool do_select = (t0 >= 256);                \
        const int roff = (half) ? 0 : (SCROW - 16 * ((t0 + 8 + 15) >> 4)); (void)ui; (void)tok0; (void)roff
#pragma unroll 1
    for (int b = 0; b < 8; ++b) {
        __syncthreads();
#pragma unroll 1
        for (int half = 0; half < 2; ++half) {
        UNIT_PARAMS(half);
        if (do_select) {
            bf16x8 Aq[2]; float sg[2][4];
#pragma unroll
            for (int g = 0; g < 2; ++g) {
                const int q = fr >> 2, hh = fr & 3;
                const bf16_t* ip = P + (tok0 + g * 4 + q) * PM_LD;
                const float wv = fabsf(bf2f(ip[PC_WI + hh]));
                const u32x4 qv = *(const u32x4*)(ip + PC_QI + hh * 32 + 8 * fq);
                u32x4 H; H.x = pk2(bf2f(qv.x & 0xffffu) * wv, bf2f(qv.x >> 16) * wv); H.y = pk2(bf2f(qv.y & 0xffffu) * wv, bf2f(qv.y >> 16) * wv);
                H.z = pk2(bf2f(qv.z & 0xffffu) * wv, bf2f(qv.z >> 16) * wv); H.w = pk2(bf2f(qv.w & 0xffffu) * wv, bf2f(qv.w >> 16) * wv);
                Aq[g] = __builtin_bit_cast(bf16x8, H);
                const bf16_t* wp = P + (tok0 + g * 4 + fq) * PM_LD + PC_WI;
#pragma unroll
                for (int r = 0; r < 4; ++r) sg[g][r] = (wp[r] & 0x8000u) ? -1.f : 1.f;
            }
            const int nT = (t0 + 8 + 15) >> 4;
            const int cnt = (nT - wave + 7) >> 3;
            const bf16_t* kbase = KIH + ((size_t)b * SEQ + fr) * 32 + 8 * fq;
#define SCORE_TILE(T, BH) do { _Pragma("unroll") for (int g = 0; g < 2; ++g) { f32x4 c = (f32x4){0.f, 0.f, 0.f, 0.f}; \
                    c = __builtin_amdgcn_mfma_f32_16x16x32_bf16(Aq[g], BH, c, 0, 0, 0); \
                    const float sc1 = (sg[g][0] * fmaxf(c[0], 0.f) + sg[g][1] * fmaxf(c[1], 0.f)) + (sg[g][2] * fmaxf(c[2], 0.f) + sg[g][3] * fmaxf(c[3], 0.f)); \
                    SC[(g * 4 + fq) * SCROW + roff + 16 * (T) + fr] = sc1 + 0.0f; } } while (0)
            int i = 0;
#pragma unroll 1
            for (; i + 4 <= cnt; i += 4) {
                const int T = wave + 8 * i;
                bf16x8 bh[4];
#pragma unroll
                for (int j = 0; j < 4; ++j) bh[j] = *(const bf16x8*)(kbase + (size_t)(16 * (T + 8 * j)) * 32);
#pragma unroll
                for (int j = 0; j < 4; ++j) SCORE_TILE(T + 8 * j, bh[j]);
            }
#pragma unroll 1
            for (; i < cnt; ++i) { const int T = wave + 8 * i;
                const bf16x8 bh1 = *(const bf16x8*)(kbase + (size_t)(16 * T) * 32);
                SCORE_TILE(T, bh1); }
#undef SCORE_TILE
        }
        }
        __syncthreads();
#pragma unroll 1
        for (int half = 0; half < 2; ++half) {
        UNIT_PARAMS(half);
        LAS unsigned short* IDXL = half ? IDXL1 : IDXL0;
        const int t = t0 + wave;
        if (do_select) {
            unsigned key[64];
            unsigned kzero = 0u; asm volatile("" : "+v"(kzero));
            const LAS float* myS = SC + wave * SCROW + roff;
            const int nr = (t >> 6) + 1;
            const int nb = (nr + 15) >> 4;
            unsigned thr = 0u, totS = 0u, cgt = 0u;
#define LOADKEYS(NB) do { _Pragma("unroll") for (int r = 0; r < 64; ++r) { unsigned u = kzero; \
                if (r < 16 * (NB)) { const int e = r * 64 + lane; u = __builtin_bit_cast(unsigned, myS[e]); u = (u & 0x80000000u) ? ~u : (u | 0x80000000u); u = (e <= t) ? u : 0u; } \
                key[r] = u; } } while (0)
#define CNT8(acc, r0, c) do { unsigned long long _t0, _t1, _t2; asm("v_cmp_le_u32 vcc, %12, %4\n\tv_cmp_le_u32_e64 %1, %12, %5\n\tv_cmp_le_u32_e64 %2, %12, %6\n\tv_cmp_le_u32_e64 %3, %12, %7\n\tv_addc_co_u32 %0, vcc, 0, %0, vcc\n\tv_addc_co_u32_e64 %0, %1, 0, %0, %1\n\tv_addc_co_u32_e64 %0, %2, 0, %0, %2\n\tv_addc_co_u32_e64 %0, %3, 0, %0, %3\n\tv_cmp_le_u32 vcc, %12, %8\n\tv_cmp_le_u32_e64 %1, %12, %9\n\tv_cmp_le_u32_e64 %2, %12, %10\n\tv_cmp_le_u32_e64 %3, %12, %11\n\tv_addc_co_u32 %0, vcc, 0, %0, vcc\n\tv_addc_co_u32_e64 %0, %1, 0, %0, %1\n\tv_addc_co_u32_e64 %0, %2, 0, %0, %2\n\tv_addc_co_u32_e64 %0, %3, 0, %0, %3" : "+v"(acc), "=&s"(_t0), "=&s"(_t1), "=&s"(_t2) : "v"(key[r0]), "v"(key[r0 + 1]), "v"(key[r0 + 2]), "v"(key[r0 + 3]), "v"(key[r0 + 4]), "v"(key[r0 + 5]), "v"(key[r0 + 6]), "v"(key[r0 + 7]), "s"(c) : "vcc"); } while (0)
#define CNT32(NB, out, lcout, cnd) do { unsigned _a0 = kzero, _a1 = kzero; const unsigned _c = (cnd); \
                _Pragma("unroll") for (int r8 = 0; r8 < 16 * (NB); r8 += 16) { CNT8(_a0, r8, _c); CNT8(_a1, r8 + 8, _c); } \
                lcout = _a0 + _a1; out = wave_sum_u32(lcout); } while (0)
#define COMPACT4(r0) do { unsigned _a; unsigned long long _t0, _t1, _t2; asm volatile("v_cmp_le_u32 vcc, %12, %6\n\tv_cmp_le_u32_e64 %3, %12, %7\n\tv_cmp_le_u32_e64 %4, %12, %8\n\tv_cmp_le_u32_e64 %5, %12, %9\n\tv_lshl_add_u32 %2, %0, 1, %10\n\tv_cndmask_b32_e64 %2, %11, %2, vcc\n\tv_addc_co_u32_e64 %0, vcc, 0, %0, vcc\n\tds_write_b16 %2, %1\n\tv_add_u32 %1, 64, %1\n\tv_lshl_add_u32 %2, %0, 1, %10\n\tv_cndmask_b32_e64 %2, %11, %2, %3\n\tv_addc_co_u32_e64 %0, %3, 0, %0, %3\n\tds_write_b16 %2, %1\n\tv_add_u32 %1, 64, %1\n\tv_lshl_add_u32 %2, %0, 1, %10\n\tv_cndmask_b32_e64 %2, %11, %2, %4\n\tv_addc_co_u32_e64 %0, %4, 0, %0, %4\n\tds_write_b16 %2, %1\n\tv_add_u32 %1, 64, %1\n\tv_lshl_add_u32 %2, %0, 1, %10\n\tv_cndmask_b32_e64 %2, %11, %2, %5\n\tv_addc_co_u32_e64 %0, %5, 0, %0, %5\n\tds_write_b16 %2, %1\n\tv_add_u32 %1, 64, %1" : "+v"(pos), "+v"(idxv), "=&v"(_a), "=&s"(_t0), "=&s"(_t1), "=&s"(_t2) : "v"(key[r0]), "v"(key[r0 + 1]), "v"(key[r0 + 2]), "v"(key[r0 + 3]), "v"(ibase), "v"(dmy), "s"(thr) : "vcc", "memory"); } while (0)
#define COMPACT_FAST(NB) do { const unsigned cntl = lcS; \
                int sc = (int)cntl; \
                sc += __builtin_amdgcn_update_dpp(0, sc, 0x111, 0xF, 0xF, true); sc += __builtin_amdgcn_update_dpp(0, sc, 0x112, 0xF, 0xF, true); \
                sc += __builtin_amdgcn_update_dpp(0, sc, 0x114, 0xF, 0xF, true); sc += __builtin_amdgcn_update_dpp(0, sc, 0x118, 0xF, 0xF, true);     \
                sc += __builtin_amdgcn_update_dpp(0, sc, 0x142, 0xA, 0xF, false); sc += __builtin_amdgcn_update_dpp(0, sc, 0x143, 0xC, 0xF, false);    \
                unsigned pos = (unsigned)sc - cntl, idxv = (unsigned)lane; \
                const unsigned ibase = (unsigned)(__UINTPTR_TYPE__)IDXL, dmy = (unsigned)(__UINTPTR_TYPE__)(LAS unsigned short*)(F.MISC + 128 + wave); \
                _Pragma("unroll") for (int r = 0; r < 16 * (NB); r += 4) COMPACT4(r); } while (0)
#define SELECT32(NB) do { LOADKEYS(NB); \
                unsigned mxl = kzero; _Pragma("unroll") for (int r = 0; r < 16 * (NB); ++r) mxl = mxl > key[r] ? mxl : key[r]; \
                unsigned mxw = wave_max_u32(mxl); mxw = mxw < 0xfffffffeu ? mxw : 0xfffffffeu; \
                unsigned lo = 0u, hi = mxw + 1u, cLo = 1024u * (NB), cHi = 0u, lcS = kzero; \
                if ((NB) >= 2) { _Pragma("unroll 1") for (int nOct = 0; nOct < 6 && cLo != 256u; ++nOct) {     \
                    if (((lo ^ (hi - 1u)) >> 23) == 0u) break; \
                    const unsigned cand = (hi - 1u) & 0xFF800000u; unsigned tot, lc; CNT32(NB, tot, lc, cand); \
                    if (tot >= 256u) { lo = cand; cLo = tot; lcS = lc; } else { hi = cand; cHi = tot; } } } \
                if (cLo != 256u) { _Pragma("unroll 1") for (;;) { const unsigned w = hi - lo; if (w <= 1u) break; \
                    const unsigned cand = lo + (w >> 1); unsigned tot, lc; CNT32(NB, tot, lc, cand); \
                    if (tot >= 256u) { lo = cand; cLo = tot; lcS = lc; if (tot == 256u) break; } else { hi = cand; cHi = tot; } } } \
                thr = lo; totS = cLo; cgt = cHi; \
                if (totS == 256u) COMPACT_FAST(NB); } while (0)
            if (nb == 1) SELECT32(1); else if (nb == 2) SELECT32(2); else if (nb == 3) SELECT32(3); else SELECT32(4);
#undef SELECT32
#undef COMPACT_FAST
#undef COMPACT4
#undef CNT32
#undef CNT8
#undef LOADKEYS
            const int need = 256 - (int)cgt;
            if (totS != 256u) {
            int selb = 0, eqb = 0;
#pragma unroll
            for (int blk = 0; blk < 8; ++blk) if (blk * 8 < nr) {
#pragma unroll
                for (int r8 = 0; r8 < 8; ++r8) { const int r = blk * 8 + r8;
                    const bool gt = key[r] > thr, eq = key[r] == thr;
                    const unsigned long long meq = __ballot(eq);
                    const int eqrank = eqb + (int)__builtin_amdgcn_mbcnt_hi((unsigned)(meq >> 32), __builtin_amdgcn_mbcnt_lo((unsigned)meq, 0u));
                    const bool sel = gt || (eq && eqrank < need);
                    const unsigned long long msel = __ballot(sel);
                    const int pos = selb + (int)__builtin_amdgcn_mbcnt_hi((unsigned)(msel >> 32), __builtin_amdgcn_mbcnt_lo((unsigned)msel, 0u));
                    if (sel && pos < 256) IDXL[pos] = (unsigned short)(r * 64 + lane);
                    selb += __popcll(msel); eqb += __popcll(meq); }
            }
            }
        } else {
#pragma unroll
            for (int j = 0; j < 4; ++j) IDXL[lane + 64 * j] = (unsigned short)(lane + 64 * j);
        }
        }
        asm volatile("s_waitcnt lgkmcnt(0)" ::: "memory");
#pragma unroll 1
        for (int half = 0; half < 2; ++half) {
        UNIT_PARAMS(half);
        LAS unsigned short* IDXL = half ? IDXL1 : IDXL0;
        const int t = t0 + wave;
        const int nsel = (t + 1 < 256) ? t + 1 : 256;
        { const int lane4 = fresh_lane(); const int fr = lane4 & 15, fq = lane4 >> 4, lane = lane4;
        bf16x8 bq[4];
#pragma unroll
        for (int kk = 0; kk < 4; ++kk) {
            u32x4 z = (u32x4){0u, 0u, 0u, 0u};
            if (fr < 8) z = *(const u32x4*)(QLG + ((size_t)(ui * 8 + wave) * 8 + fr) * 128 + 32 * kk + 8 * fq);
            bq[kk] = __builtin_bit_cast(bf16x8, z);
        }
        f32x4 o[8];
#pragma unroll
        for (int mt = 0; mt < 8; ++mt) o[mt] = (f32x4){0.f, 0.f, 0.f, 0.f};
        float mrun = -INFINITY, lsum = 0.f;
        const int nch = (nsel + 31) >> 5;
        const int q4 = fr >> 2, p4 = fr & 3;
        const unsigned swr = (unsigned)(((fr & 3) << 2) | ((fr >> 2) & 3)), swt = (unsigned)((q4 << 2) | fq);
        LAS unsigned char* apA[4]; LAS unsigned char* apT[8];
#pragma unroll
        for (int kk = 0; kk < 4; ++kk) apA[kk] = myreg + 256 * fr + 16 * ((unsigned)(4 * kk + fq) ^ swr);
#pragma unroll
        for (int mt = 0; mt < 8; ++mt) apT[mt] = myreg + 256 * (4 * fq + q4) + 16 * ((unsigned)(2 * mt + (p4 >> 1)) ^ swt) + 8 * (p4 & 1);
        unsigned dsw4[4];
#pragma unroll
        for (int j = 0; j < 4; ++j) dsw4[j] = ((unsigned)fr ^ (unsigned)((fq << 2) | j)) << 4;
        const __amdgpu_buffer_rsrc_t rck = __builtin_amdgcn_make_buffer_rsrc((void*)(CKVN + (size_t)b * SEQ * 128), (short)0, SEQ * 256, 0x00020000);
#define DMA_CHUNK(cc, BUF) do { _Pragma("unroll") for (int i = 0; i < 8; ++i) { const unsigned rowi = IDXL[(cc) * 32 + 4 * i + fq];     \
            __builtin_amdgcn_raw_ptr_buffer_load_lds(rck, (LAS unsigned*)(myreg + (BUF) * 8192 + i * 1024), 16, (int)(rowi * 256u + dsw4[i & 3]), 0, 0, 0); } } while (0)
#define LDS_R128(dst, ptr, off) asm volatile("ds_read_b128 %0, %1 offset:%2" : "=v"(dst) : "v"((unsigned)(__UINTPTR_TYPE__)(ptr)), "n"(off))
#define LDS_TR64(dst, ptr, off) asm volatile("ds_read_b64_tr_b16 %0, %1 offset:%2" : "=v"(dst) : "v"((unsigned)(__UINTPTR_TYPE__)(ptr)), "n"(off))
#define COMPUTE_CHUNK(ch, BUF, MASKED) do { \
            bf16x8 Ak[2][4]; \
            _Pragma("unroll") for (int T = 0; T < 2; ++T) _Pragma("unroll") for (int kk = 0; kk < 4; ++kk) LDS_R128(Ak[T][kk], apA[kk], (BUF) * 8192 + 4096 * T); \
            s16x4 tr0[4], tr1[4]; \
            _Pragma("unroll") for (int mt = 0; mt < 4; ++mt) { LDS_TR64(tr0[mt], apT[mt], (BUF) * 8192); LDS_TR64(tr1[mt], apT[mt], (BUF) * 8192 + 4096); } \
            asm volatile("s_waitcnt lgkmcnt(8)" ::: "memory"); __builtin_amdgcn_sched_barrier(0);     \
            f32x4 s[2]; \
            _Pragma("unroll") for (int T = 0; T < 2; ++T) { s[T] = (f32x4){0.f, 0.f, 0.f, 0.f}; \
                _Pragma("unroll") for (int kk = 0; kk < 4; ++kk) s[T] = __builtin_amdgcn_mfma_f32_16x16x32_bf16(Ak[T][kk], bq[kk], s[T], 0, 0, 0); } \
            if (MASKED) { _Pragma("unroll") for (int T = 0; T < 2; ++T) _Pragma("unroll") for (int r = 0; r < 4; ++r) { const int slot = (ch) * 32 + 16 * T + 4 * fq + r; s[T][r] = (slot < nsel) ? s[T][r] : -INFINITY; } } \
            if ((ch) == 0) { float cmax = fmaxf(fmaxf(fmaxf(s[0][0], s[0][1]), fmaxf(s[0][2], s[0][3])), fmaxf(fmaxf(s[1][0], s[1][1]), fmaxf(s[1][2], s[1][3]))); \
                cmax = fmaxf(cmax, shfl_xor_f(cmax, 16, lane)); cmax = fmaxf(cmax, shfl_xor_f(cmax, 32, lane)); mrun = cmax; } \
            _Pragma("unroll") for (int T = 0; T < 2; ++T) _Pragma("unroll") for (int r = 0; r < 4; ++r) { const float p = __builtin_amdgcn_exp2f(s[T][r] - mrun); s[T][r] = p; lsum += p; } \
            u32x4 pk; pk.x = pk2(s[0][0], s[0][1]); pk.y = pk2(s[0][2], s[0][3]); pk.z = pk2(s[1][0], s[1][1]); pk.w = pk2(s[1][2], s[1][3]); \
            const bf16x8 Bp = __builtin_bit_cast(bf16x8, pk); \
            asm volatile("s_waitcnt lgkmcnt(0)" ::: "memory"); __builtin_amdgcn_sched_barrier(0); \
            bf16x8 Av4[4]; \
            _Pragma("unroll") for (int mt = 0; mt < 4; ++mt) Av4[mt] = __builtin_shufflevector(tr0[mt], tr1[mt], 0, 1, 2, 3, 4, 5, 6, 7); \
            _Pragma("unroll") for (int mt = 0; mt < 4; ++mt) { LDS_TR64(tr0[mt], apT[mt + 4], (BUF) * 8192); LDS_TR64(tr1[mt], apT[mt + 4], (BUF) * 8192 + 4096); } \
            _Pragma("unroll") for (int mt = 0; mt < 4; ++mt) o[mt] = __builtin_amdgcn_mfma_f32_16x16x32_bf16(Av4[mt], Bp, o[mt], 0, 0, 0); \
            asm volatile("s_waitcnt lgkmcnt(0)" ::: "memory"); __builtin_amdgcn_sched_barrier(0); \
            _Pragma("unroll") for (int mt = 0; mt < 4; ++mt) { \
                const bf16x8 Av = __builtin_shufflevector(tr0[mt], tr1[mt], 0, 1, 2, 3, 4, 5, 6, 7); \
                o[mt + 4] = __builtin_amdgcn_mfma_f32_16x16x32_bf16(Av, Bp, o[mt + 4], 0, 0, 0); } } while (0)
#define VM_WAIT(n) asm volatile("s_waitcnt vmcnt(" #n ")" ::: "memory")
        if (nsel == 256) {
            DMA_CHUNK(0, 0); DMA_CHUNK(1, 1);
            VM_WAIT(8); COMPUTE_CHUNK(0, 0, false); DMA_CHUNK(2, 0);
            VM_WAIT(8); COMPUTE_CHUNK(1, 1, false); DMA_CHUNK(3, 1);
            VM_WAIT(8); COMPUTE_CHUNK(2, 0, false); DMA_CHUNK(4, 0);
            VM_WAIT(8); COMPUTE_CHUNK(3, 1, false); DMA_CHUNK(5, 1);
            VM_WAIT(8); COMPUTE_CHUNK(4, 0, false); DMA_CHUNK(6, 0);
            VM_WAIT(8); COMPUTE_CHUNK(5, 1, false); DMA_CHUNK(7, 1);
            VM_WAIT(8); COMPUTE_CHUNK(6, 0, false);
            VM_WAIT(0); COMPUTE_CHUNK(7, 1, false);
        } else {
#pragma unroll 1
            for (int ch = 0; ch < nch; ++ch) { DMA_CHUNK(ch, 0); VM_WAIT(0); COMPUTE_CHUNK(ch, 0, true); }
        }
#undef VM_WAIT
#undef DMA_CHUNK
#undef COMPUTE_CHUNK
        lsum += shfl_xor_f(lsum, 16, lane); lsum += shfl_xor_f(lsum, 32, lane);
        const float linv = 1.f / lsum;
        if (fr < 8) {
#pragma unroll
            for (int mt = 0; mt < 8; ++mt) { u32x2 w2; w2.x = pk2(o[mt][0] * linv, o[mt][1] * linv); w2.y = pk2(o[mt][2] * linv, o[mt][3] * linv);
                *(u32x2*)(OLG + ((size_t)(ui * 8 + wave) * 8 + fr) * 128 + 16 * mt + 4 * fq) = w2; }
        }
        }
        }
    }
#undef UNIT_PARAMS
    asm volatile("s_waitcnt vmcnt(0)" ::: "memory");
    __syncthreads();
    {
        const int lane5 = fresh_lane(); const int fr = lane5 & 15, fq = lane5 >> 4;
        const int h = wave;
        bf16x8 Bv[4][4];
#pragma unroll
        for (int nt = 0; nt < 4; ++nt)
#pragma unroll
            for (int kk = 0; kk < 4; ++kk) Bv[nt][kk] = *(const bf16x8*)(WUV + ((size_t)h * 64 + nt * 16 + fr) * 128 + 32 * kk + 8 * fq);
#pragma unroll 1
        for (int mt = 0; mt < 8; ++mt) {
            const int qi = 16 * mt + fr;
            const bf16_t* op = OLG + ((size_t)qi * 8 + h) * 128 + 8 * fq;
            bf16x8 Ao[4];
#pragma unroll
            for (int kk = 0; kk < 4; ++kk) Ao[kk] = *(const bf16x8*)(op + 32 * kk);
            bf16_t* outp = OAB + TOK_OF(qi) * 1024 + h * 64 + 4 * fq;
#pragma unroll
            for (int nt = 0; nt < 4; ++nt) {
                f32x4 c = (f32x4){0.f, 0.f, 0.f, 0.f};
#pragma unroll
                for (int kk = 0; kk < 4; ++kk) c = __builtin_amdgcn_mfma_f32_16x16x32_bf16(Bv[nt][kk], Ao[kk], c, 0, 0, 0);
                u32x2 w2; w2.x = pk2(c[0], c[1]); w2.y = pk2(c[2], c[3]);
                *(u32x2*)(outp + 16 * nt) = w2;
            }
        }
    }
#undef TOK_OF
    __syncthreads();
}

__device__ __forceinline__ void phase_route(const Args& a, Frame& F, int l) {
    const float* LG = (const float*)(F.ws + WS_IDXP);
    int* TOPE = (int*)(F.ws + WS_RT); float* TOPW = (float*)(F.ws + WS_RT + 512 * 1024); int* RANK = (int*)(F.ws + WS_RT + 1024 * 1024);
    unsigned* CNT = (unsigned*)(F.ctl + CW_MOE + l * CW_MOE_STRIDE);
    const float* br = a.in[I_BR] + (size_t)l * 32;
    volatile LAS unsigned* lc = F.MISC + 32;
    const int tid = F.wave * 64 + fresh_lane();
    for (int chunk = F.vcu; chunk < NTOK / NTHREADS; chunk += F.G) {
        if (tid < 32) lc[tid] = 0u;
        __syncthreads();
        const int row = chunk * NTHREADS + tid;
        float v[32];
#pragma unroll
        for (int j = 0; j < 8; ++j) { const f32x4 t4 = *(const f32x4*)(LG + (size_t)row * IDX_LD + 4 * j); const f32x4 b4 = *(const f32x4*)(br + 4 * j);
            v[4 * j] = t4[0] + b4[0]; v[4 * j + 1] = t4[1] + b4[1]; v[4 * j + 2] = t4[2] + b4[2]; v[4 * j + 3] = t4[3] + b4[3]; }
        unsigned taken = 0u; float tv[4]; int te[4];
#pragma unroll
        for (int k = 0; k < 4; ++k) {
            float best = -INFINITY; int bi = 0;
#pragma unroll
            for (int e = 0; e < 32; ++e) { const bool ok = !((taken >> e) & 1u) && (v[e] > best); best = ok ? v[e] : best; bi = ok ? e : bi; }
            taken |= 1u << bi; tv[k] = best; te[k] = bi;
        }
        float ex[4], es = 0.f;
#pragma unroll
        for (int k = 0; k < 4; ++k) { ex[k] = __expf(tv[k] - tv[0]); es += ex[k]; }
        int rk[4];
#pragma unroll
        for (int k = 0; k < 4; ++k) { TOPE[row * 4 + k] = te[k]; TOPW[row * 4 + k] = ex[k] / es; rk[k] = (int)__hip_atomic_fetch_add((LAS unsigned*)&lc[te[k]], 1u, __ATOMIC_RELAXED, __HIP_MEMORY_SCOPE_WORKGROUP); }
        __syncthreads();
        if (tid < 32) lc[64 + tid] = __hip_atomic_fetch_add(&CNT[tid], lc[tid], __ATOMIC_RELAXED, __HIP_MEMORY_SCOPE_AGENT);
        __syncthreads();
#pragma unroll
        for (int k = 0; k < 4; ++k) RANK[row * 4 + k] = (int)lc[64 + te[k]] + rk[k];
        __syncthreads();
    }
}
__device__ __forceinline__ void phase_norm2_route(const Args& a, Frame& F, int l) {
    const int lane = fresh_lane(), fr = lane & 15, fq = lane >> 4, tid = F.wave * 64 + lane;
    const bf16_t* X1 = (const bf16_t*)(F.ws + WS_X1);
    bf16_t* HC = (bf16_t*)(F.ws + WS_HC);
    const bf16_t* WRP = (const bf16_t*)(F.ws + WS_W + (size_t)l * WL_BYTES + WO_WRP);
    int* TOPE = (int*)(F.ws + WS_RT); float* TOPW = (float*)(F.ws + WS_RT + 512 * 1024); int* RANK = (int*)(F.ws + WS_RT + 1024 * 1024);
    unsigned* CNT = (unsigned*)(F.ctl + CW_MOE + l * CW_MOE_STRIDE);
    const float* br = a.in[I_BR] + (size_t)l * 32;
    volatile LAS unsigned* lc = F.MISC + 32;
    LAS float* gm = (LAS float*)F.lds; LAS float* shv = gm + 1024;
    LAS float* lt = (LAS float*)(F.lds + 8192) + F.wave * (16 * 33);
    const int b = (F.vcu * 128) / SEQ;
    const float* ada_b = (const float*)(F.ws + WS_ADA) + ((size_t)l * 8 + b) * 6144;
    const float* gam = a.in[I_N2G] + (size_t)l * DM;
    for (int i = tid; i < 1024; i += NTHREADS) { gm[i] = gam[i] * (1.f + ada_b[4096 + i]); shv[i] = ada_b[3072 + i]; }
    if (tid < 32) lc[tid] = 0u;
    __syncthreads();
    const int row = F.gw * 16 + fr;
    const bf16_t* __restrict__ xr = X1 + (size_t)row * DM + 8 * fq;
#define LD_X8(v0, v1, p) const u32x4 _xb = *(const u32x4*)(p); const f32x4 v0 = {bf2f(_xb.x & 0xffffu), bf2f(_xb.x >> 16), bf2f(_xb.y & 0xffffu), bf2f(_xb.y >> 16)}, v1 = {bf2f(_xb.z & 0xffffu), bf2f(_xb.z >> 16), bf2f(_xb.w & 0xffffu), bf2f(_xb.w >> 16)}
    float ss = 0.f;
#pragma unroll 16
    for (int kk = 0; kk < 32; ++kk) { LD_X8(v0, v1, xr + 32 * kk);
        ss += (v0[0] * v0[0] + v0[1] * v0[1]) + (v0[2] * v0[2] + v0[3] * v0[3]) + (v1[0] * v1[0] + v1[1] * v1[1]) + (v1[2] * v1[2] + v1[3] * v1[3]); }
    ss += shfl_xor_f(ss, 16, lane); ss += shfl_xor_f(ss, 32, lane);
    const float rstd = 1.0f / sqrtf(ss * (1.f / DM) + RMS_EPS);
    f32x4 acc[2] = {(f32x4){0.f, 0.f, 0.f, 0.f}, (f32x4){0.f, 0.f, 0.f, 0.f}};
    bf16_t* __restrict__ hrow = HC + (size_t)row * 1024 + 8 * fq;
    const bf16_t* __restrict__ wb = WRP + (size_t)fr * 3072 + 8 * fq;
#pragma unroll 4
    for (int kk = 0; kk < 32; ++kk) {
        LD_X8(v0, v1, xr + 32 * kk);
        const f32x4 g0 = *(const LAS f32x4*)(gm + 32 * kk + 8 * fq), g1 = *(const LAS f32x4*)(gm + 32 * kk + 8 * fq + 4);
        const f32x4 s0 = *(const LAS f32x4*)(shv + 32 * kk + 8 * fq), s1 = *(const LAS f32x4*)(shv + 32 * kk + 8 * fq + 4);
        const f32x4 h0 = (v0 * rstd) * g0 + s0, h1 = (v1 * rstd) * g1 + s1;
        u32x4 H; H.x = pk2(h0[0], h0[1]); H.y = pk2(h0[2], h0[3]); H.z = pk2(h1[0], h1[1]); H.w = pk2(h1[2], h1[3]);
        *(u32x4*)(hrow + 32 * kk) = H;
        u32x4 Lo; Lo.x = pk2(h0[0] - bf2f(H.x & 0xffffu), h0[1] - bf2f(H.x >> 16)); Lo.y = pk2(h0[2] - bf2f(H.y & 0xffffu), h0[3] - bf2f(H.y >> 16));
        Lo.z = pk2(h1[0] - bf2f(H.z & 0xffffu), h1[1] - bf2f(H.z >> 16)); Lo.w = pk2(h1[2] - bf2f(H.w & 0xffffu), h1[3] - bf2f(H.w >> 16));
        const bf16x8 Ah = __builtin_bit_cast(bf16x8, H), Al = __builtin_bit_cast(bf16x8, Lo);
#pragma unroll
        for (int nt = 0; nt < 2; ++nt) {
            const bf16x8 bh = *(const bf16x8*)(wb + (size_t)nt * 16 * 3072 + 32 * kk), bl = *(const bf16x8*)(wb + (size_t)nt * 16 * 3072 + 2048 + 32 * kk);
            acc[nt] = __builtin_amdgcn_mfma_f32_16x16x32_bf16(Al, bh, acc[nt], 0, 0, 0);
            acc[nt] = __builtin_amdgcn_mfma_f32_16x16x32_bf16(Ah, bl, acc[nt], 0, 0, 0);
            acc[nt] = __builtin_amdgcn_mfma_f32_16x16x32_bf16(Ah, bh, acc[nt], 0, 0, 0);
        }
    }
#pragma unroll
    for (int nt = 0; nt < 2; ++nt) { const float bias = br[fr + 16 * nt];
#pragma unroll
        for (int r = 0; r < 4; ++r) lt[(4 * fq + r) * 33 + fr + 16 * nt] = acc[nt][r] + bias; }
    asm volatile("s_waitcnt lgkmcnt(0)" ::: "memory");
    int te[4] = {0, 0, 0, 0}, rk[4] = {0, 0, 0, 0};
    const int orow = F.gw * 16 + lane;
    if (lane < 16) {
        float v[32];
#pragma unroll
        for (int e = 0; e < 32; ++e) v[e] = lt[lane * 33 + e];
        unsigned taken = 0u; float tv[4];
#pragma unroll
        for (int k = 0; k < 4; ++k) {
            float best = -INFINITY; int bi = 0;
#pragma unroll
            for (int e = 0; e < 32; ++e) { const bool ok = !((taken >> e) & 1u) && (v[e] > best); best = ok ? v[e] : best; bi = ok ? e : bi; }
            taken |= 1u << bi; tv[k] = best; te[k] = bi;
        }
        float ex[4], es = 0.f;
#pragma unroll
        for (int k = 0; k < 4; ++k) { ex[k] = __expf(tv[k] - tv[0]); es += ex[k]; }
        const float inv = 1.f / es;
        *(int4*)(TOPE + orow * 4) = make_int4(te[0], te[1], te[2], te[3]);
        *(float4*)(TOPW + orow * 4) = make_float4(ex[0] * inv, ex[1] * inv, ex[2] * inv, ex[3] * inv);
#pragma unroll
        for (int k = 0; k < 4; ++k) rk[k] = (int)__hip_atomic_fetch_add((LAS unsigned*)&lc[te[k]], 1u, __ATOMIC_RELAXED, __HIP_MEMORY_SCOPE_WORKGROUP);
    }
    __syncthreads();
    if (tid < 32) lc[64 + tid] = __hip_atomic_fetch_add(&CNT[tid], lc[tid], __ATOMIC_RELAXED, __HIP_MEMORY_SCOPE_AGENT);
    __syncthreads();
    if (lane < 16) *(int4*)(RANK + orow * 4) = make_int4((int)lc[64 + te[0]] + rk[0], (int)lc[64 + te[1]] + rk[1], (int)lc[64 + te[2]] + rk[2], (int)lc[64 + te[3]] + rk[3]);
    __syncthreads();
}
__device__ __forceinline__ void phase_dispatch(Frame& F, int l) {
    const int* TOPE = (const int*)(F.ws + WS_RT); const int* RANK = (const int*)(F.ws + WS_RT + 1024 * 1024); int* DEST = (int*)(F.ws + WS_RT + 1536 * 1024);
    int* PERM = (int*)(F.ws + WS_RT + 2048 * 1024);
    unsigned* CNT = (unsigned*)(F.ctl + CW_MOE + l * CW_MOE_STRIDE);
    const int lane = fresh_lane();
    const int cnt = (lane < 32) ? (int)CNT[lane] : 0;
    const int padded = (cnt + 255) & ~255;
    int start = 0;
#pragma unroll
    for (int j = 0; j < 32; ++j) { const int pj = __builtin_amdgcn_readlane(padded, j); start += (j < lane) ? pj : 0; }
    if (F.vcu == 0 && F.wave == 0) {
        int* tinfo = (int*)(CNT);
        if (lane < 32) { const int nt = padded >> 8, tb = start >> 8; for (int j = 0; j < nt; ++j) tinfo[64 + tb + j] = lane;
            int pz = 0; asm volatile("" : "+v"(pz));
#pragma clang loop vectorize(disable) unroll(disable)
            for (int r = cnt; r < padded; ++r) PERM[start + r] = pz; }
        if (lane == 31) tinfo[32] = (start + padded) >> 8;
    }
    for (int as = F.gw * 64 + lane; as < NASG; as += F.NGW * 64) {
        const int e = TOPE[as];
        const int dest = __builtin_amdgcn_ds_bpermute(e << 2, start) + RANK[as];
        DEST[as] = dest; PERM[dest] = as >> 2;
    }
}
__device__ __forceinline__ void phase_combine(const Args& a, Frame& F, int l) {
    const bf16_t* __restrict__ X1 = (const bf16_t*)(F.ws + WS_X1); bf16_t* __restrict__ X = (bf16_t*)(F.ws + WS_X);
    const bf16_t* __restrict__ YS = (const bf16_t*)(F.ws + WS_YS);
    const float* __restrict__ TOPW = (const float*)(F.ws + WS_RT + 512 * 1024); const int* __restrict__ DEST = (const int*)(F.ws + WS_RT + 1536 * 1024);
    bf16_t* __restrict__ HCo = (bf16_t*)(F.ws + WS_HC); float* __restrict__ outp = a.out;
    const float* ada = (const float*)(F.ws + WS_ADA);
    const int lane = fresh_lane();
    for (int grp = F.gw; grp < NTOK / 16; grp += F.NGW) {
        const int b = (grp * 16) / SEQ;
        const float* g2 = ada + ((size_t)l * 8 + b) * 6144 + 5120;
        f32x4 g2v[4], gmv[4], shv[4], fgv[4];
#pragma unroll
        for (int j = 0; j < 4; ++j) { const int c = 4 * lane + 256 * j; g2v[j] = *(const f32x4*)(g2 + c);
            if (l + 1 < DEPTH) { const float* ab = ada + ((size_t)(l + 1) * 8 + b) * 6144;
                gmv[j] = *(const f32x4*)(a.in[I_N1G] + (size_t)(l + 1) * DM + c) * (*(const f32x4*)(ab + 1024 + c) + 1.f); shv[j] = *(const f32x4*)(ab + c); }
            else fgv[j] = *(const f32x4*)(a.in[I_FG] + c); }
#pragma unroll 2
        for (int rr = 0; rr < 16; ++rr) {
            const int row = grp * 16 + rr;
            const f32x4 wv = *(const f32x4*)(TOPW + row * 4); const int4 dv = *(const int4*)(DEST + row * 4);
            const float w4[4] = {wv[0], wv[1], wv[2], wv[3]}; const int d4[4] = {dv.x, dv.y, dv.z, dv.w};
            f32x4 m[4];
#pragma unroll
            for (int j = 0; j < 4; ++j) m[j] = (f32x4){0.f, 0.f, 0.f, 0.f};
#pragma unroll
            for (int k = 0; k < 4; ++k) {
                const bf16_t* yr = YS + (size_t)d4[k] * 1024 + 4 * lane;
#pragma unroll
                for (int j = 0; j < 4; ++j) { const u32x2 yv = *(const u32x2*)(yr + 256 * j);
                    m[j][0] += w4[k] * bf2f(yv.x & 0xffffu); m[j][1] += w4[k] * bf2f(yv.x >> 16); m[j][2] += w4[k] * bf2f(yv.y & 0xffffu); m[j][3] += w4[k] * bf2f(yv.y >> 16); }
            }
            f32x4 v[4]; float ss = 0.f;
#pragma unroll
            for (int j = 0; j < 4; ++j) { const int c = 4 * lane + 256 * j;
                const u32x2 xb = *(const u32x2*)(X1 + (size_t)row * DM + c);
                v[j] = (f32x4){bf2f(xb.x & 0xffffu), bf2f(xb.x >> 16), bf2f(xb.y & 0xffffu), bf2f(xb.y >> 16)} + g2v[j] * m[j];
                ss += (v[j][0] * v[j][0] + v[j][1] * v[j][1]) + (v[j][2] * v[j][2] + v[j][3] * v[j][3]); }
            const float rstd = 1.0f / sqrtf(wave_sum(ss) * (1.f / DM) + RMS_EPS);
            if (l + 1 < DEPTH) {
                f32x4 h[4];
#pragma unroll
                for (int j = 0; j < 4; ++j) { u32x2 xo; xo.x = pk2(v[j][0], v[j][1]); xo.y = pk2(v[j][2], v[j][3]); *(u32x2*)(X + (size_t)row * DM + 4 * lane + 256 * j) = xo; h[j] = (v[j] * rstd) * gmv[j] + shv[j]; }
                store_hilo(HCo + (size_t)row * 1024, lane, h);
            } else {
#pragma unroll
                for (int j = 0; j < 4; ++j) *(f32x4*)(outp + (size_t)row * DM + 4 * lane + 256 * j) = v[j] * rstd * fgv[j];
            }
        }
    }
}

constexpr int NPH = 11;
constexpr int NSTEPS = 1 + DEPTH * NPH;
__global__ void __launch_bounds__(NTHREADS, 2) fwd_kernel(Args args) {
    extern __shared__ __attribute__((aligned(16))) unsigned char lds_raw[];
    Frame F;
    F.lds = (LAS unsigned char*)lds_raw; F.MISC = (volatile LAS unsigned*)(F.lds + MISC_OFF);
    F.wave = __builtin_amdgcn_readfirstlane((int)threadIdx.x >> 6);
    F.G = 256; { const int bx = blockIdx.x; F.vcu = (bx & 7) * 32 + (bx >> 3); }
    F.gw = F.vcu * NWAVES + F.wave; F.NGW = F.G * NWAVES;
    F.ws = (GAS unsigned char*)args.ws; F.ctl = (GAS unsigned*)(args.ws + WS_CTL);
    for (int u = threadIdx.x; u < 256; u += NTHREADS) F.MISC[u] = 0u;
    __syncthreads();
    XcdBarrier bar; bar.bar = (unsigned*)(F.ctl + CW_BAR); bar.x = 0; bar.st = nullptr;
    if (args.use_bar) bar = xcd_barrier_post((unsigned*)(F.ctl + CW_BAR), F.MISC + 8);
    const int lo = args.ph_lo, hi = args.ph_hi;
#ifndef PH_MASK
#define PH_MASK 0xffffffffu
#endif
#define PHON(p) (((PH_MASK) >> (p)) & 1u)
#ifndef REP_MASK
#define REP_MASK 0u
#endif
#define NREP(p) ((((REP_MASK) >> (p)) & 1u) ? 2 : 1)
#define IN(k) (lo <= (k) && (k) < hi)
#define SEAM(k) do { if (IN(k) && IN((k) + 1)) xcd_barrier(bar); } while (0)
    if (PHON(11) && IN(0)) { phase_prologue(args, F); }
    SEAM(0);
    for (int l = 0; l < DEPTH; ++l) {
        int bx = blockIdx.x;
        { unsigned char* w2 = args.ws; int wv = F.wave; asm volatile("" : "+s"(w2), "+s"(bx), "+s"(wv)); F.ws = (GAS unsigned char*)w2; F.ctl = (GAS unsigned*)(w2 + WS_CTL); F.wave = wv;
          F.vcu = (bx & 7) * 32 + (bx >> 3); F.gw = F.vcu * NWAVES + F.wave; }
        const int s0 = 1 + l * NPH;
        GAS unsigned char* wl = F.ws + WS_W + (size_t)l * WL_BYTES;
        const float* ada_l = (const float*)(F.ws + WS_ADA) + (size_t)l * 8 * 6144;
        _Pragma("unroll 1") for (int rep = 0; rep < NREP(0); ++rep) if (PHON(0) && IN(s0 + 0)) { if (l == 0) phase_norm(F, args.in[I_X], args.in[I_N1G], ada_l, 0, 1024); }
        if (l == 0) SEAM(s0 + 0);
        _Pragma("unroll 1") for (int rep = 0; rep < NREP(1); ++rep) if (PHON(1) && IN(s0 + 1)) {
            pg8::Gemm g{(const bf16_t*)(F.ws + WS_HC), (const bf16_t*)(wl + WO_INMAIN), 1024, 1024, 1024, 0x7fffffff};
            pg8::StaticOrder S; S.init(NTOK, PM_LD, F.G, bx);
            pg8::EpiInMain E{(bf16_t*)(F.ws + WS_P)};
            pg8::gemm_phase<pg8::EpiInMain, pg8::StaticOrder>(F.lds, g, S, E, F.wave);
        }
        SEAM(s0 + 1);
        _Pragma("unroll 1") for (int rep = 0; rep < NREP(2); ++rep) if (PHON(2) && IN(s0 + 2)) phase_prep(args, F, l);
        SEAM(s0 + 2);
        _Pragma("unroll 1") for (int rep = 0; rep < NREP(3); ++rep) if (PHON(3) && IN(s0 + 3)) phase_attention(args, F, l);
        SEAM(s0 + 3);
        _Pragma("unroll 1") for (int rep = 0; rep < NREP(4); ++rep) if (PHON(4) && IN(s0 + 4)) {
            pg8::Gemm g{(const bf16_t*)(F.ws + WS_OAB), (const bf16_t*)(wl + WO_WA), 1024, 1024, 1024, 0x7fffffff};
            pg8::StaticOrder S; S.init(NTOK, 1024, F.G, bx);
            pg8::EpiGate E{(bf16_t*)(F.ws + WS_MG), (const bf16_t*)(F.ws + WS_P)};
            pg8::gemm_phase<pg8::EpiGate, pg8::StaticOrder>(F.lds, g, S, E, F.wave);
        }
        SEAM(s0 + 4);
        _Pragma("unroll 1") for (int rep = 0; rep < NREP(5); ++rep) if (PHON(5) && IN(s0 + 5)) {
            pg8::Gemm g{(const bf16_t*)(F.ws + WS_MG), (const bf16_t*)(wl + WO_WOUT), 1024, 1024, 1024, 0x7fffffff};
            pg8::StaticOrder S; S.init(NTOK, 1024, F.G, bx);
            if (l == 0) { pg8::EpiWout<false> E{(bf16_t*)(F.ws + WS_X1), (const void*)args.in[I_X], ada_l + 2048};
                pg8::gemm_phase<pg8::EpiWout<false>, pg8::StaticOrder>(F.lds, g, S, E, F.wave); }
            else { pg8::EpiWout<true> E{(bf16_t*)(F.ws + WS_X1), (const void*)(F.ws + WS_X), ada_l + 2048};
                pg8::gemm_phase<pg8::EpiWout<true>, pg8::StaticOrder>(F.lds, g, S, E, F.wave); }
        }
        SEAM(s0 + 5);
        _Pragma("unroll 1") for (int rep = 0; rep < NREP(6); ++rep) if (PHON(6) && IN(s0 + 6)) phase_norm2_route(args, F, l);
        SEAM(s0 + 6);
        _Pragma("unroll 1") for (int rep = 0; rep < NREP(7); ++rep) if (PHON(7) && IN(s0 + 7)) phase_dispatch(F, l);
        SEAM(s0 + 7);
        _Pragma("unroll 1") for (int rep = 0; rep < NREP(8); ++rep) if (PHON(8) && IN(s0 + 8)) {
            const int* tinfo = (const int*)(F.ctl + CW_MOE + l * CW_MOE_STRIDE);
            pg8::Gemm g{(const bf16_t*)(F.ws + WS_HC), (const bf16_t*)(wl + WO_WGU), 1024, 1024, 1024, 0x7fffffff, (const int*)(F.ws + WS_RT + 2048 * 1024)};
            pg8::GroupedOrder S{tinfo + 64, tinfo[32], F.G, F.vcu};
            pg8::EpiGU E{(bf16_t*)(F.ws + WS_ACT), args.in[I_BGU] + (size_t)l * 32 * 1024};
            pg8::gemm_phase<pg8::EpiGU, pg8::GroupedOrder, true>(F.lds, g, S, E, F.wave);
        }
        SEAM(s0 + 8);
        _Pragma("unroll 1") for (int rep = 0; rep < NREP(9); ++rep) if (PHON(9) && IN(s0 + 9)) {
            const int* tinfo = (const int*)(F.ctl + CW_MOE + l * CW_MOE_STRIDE);
            pg8::Gemm g{(const bf16_t*)(F.ws + WS_ACT), (const bf16_t*)(wl + WO_WDN), 512, 512, 512, 0x7fffffff};
            pg8::GroupedOrder S{tinfo + 64, tinfo[32], F.G, F.vcu};
            pg8::EpiDown E{(bf16_t*)(F.ws + WS_YS), args.in[I_BDN] + (size_t)l * 32 * 1024};
            pg8::gemm_phase<pg8::EpiDown, pg8::GroupedOrder>(F.lds, g, S, E, F.wave);
        }
        SEAM(s0 + 9);
        _Pragma("unroll 1") for (int rep = 0; rep < NREP(10); ++rep) if (PHON(10) && IN(s0 + 10)) phase_combine(args, F, l);
        SEAM(s0 + 10);
    }
}

extern "C" void kernel_launch(void* const* d_in, const int* in_sizes, int n_in, void* d_out, int out_size, void* d_ws, size_t ws_size, hipStream_t stream) {
    static int grid = 0;
    if (grid == 0) {
        if (n_in != 22 || ws_size < WS_END) { fprintf(stderr, "kernel_launch: unexpected inputs (n_in %d, ws %zu)\n", n_in, ws_size); grid = -1; return; }
        int dev = 0, cus = 0, per_cu = 0;
        if (hipGetDevice(&dev) != hipSuccess || hipDeviceGetAttribute(&cus, hipDeviceAttributeMultiprocessorCount, dev) != hipSuccess) { grid = -1; return; }
        if (hipFuncSetAttribute((const void*)fwd_kernel, hipFuncAttributeMaxDynamicSharedMemorySize, LDS_BYTES) != hipSuccess) { fprintf(stderr, "kernel_launch: hipFuncSetAttribute failed\n"); grid = -1; return; }
        if (hipOccupancyMaxActiveBlocksPerMultiprocessor(&per_cu, (const void*)fwd_kernel, NTHREADS, LDS_BYTES) != hipSuccess || per_cu < 1) fprintf(stderr, "kernel_launch: occupancy query says %d\n", per_cu);
        (void)hipGetLastError();
        if (cus < 256) { fprintf(stderr, "kernel_launch: needs 256 CUs, device has %d\n", cus); grid = -1; return; }
        grid = 256;
    }
    if (grid < 0) return;
    (void)hipMemsetAsync((char*)d_ws + WS_CTL, 0, CTL_BYTES, stream);
    Args a; memset(&a, 0, sizeof(a));
    for (int i = 0; i < 22; ++i) a.in[i] = (const float*)d_in[i];
    a.out = (float*)d_out; a.ws = (unsigned char*)d_ws;
#if MK_MULTI
    a.use_bar = 0;
    for (int s = 0; s < NSTEPS; ++s) {
        if (s > 0) { const int l = (s - 1) / NPH, p = (s - 1) % NPH; if (p == 0 && l > 0) continue; }
        a.ph_lo = s; a.ph_hi = s + 1;
        hipLaunchKernelGGL(fwd_kernel, dim3(grid), dim3(NTHREADS), LDS_BYTES, stream, a);
#ifdef HOST_REP_MASK
        if ((s > 0 && ((HOST_REP_MASK >> ((s - 1) % NPH)) & 1)) || (s == 0 && ((HOST_REP_MASK >> 30) & 1))) hipLaunchKernelGGL(fwd_kernel, dim3(grid), dim3(NTHREADS), LDS_BYTES, stream, a);
#endif
    }
#else
    a.use_bar = 1; a.ph_lo = 0; a.ph_hi = NSTEPS;
    hipLaunchKernelGGL(fwd_kernel, dim3(grid), dim3(NTHREADS), LDS_BYTES, stream, a);
#endif
}
```

```cpp
#include <hip/hip_runtime.h>
#include <cstdint>
#include <cstdio>
#include <cstring>

#ifndef MK_MULTI
#define MK_MULTI 0
#endif

#define GAS __attribute__((address_space(1)))
#define LAS __attribute__((address_space(3)))
typedef unsigned short bf16_t;
typedef short bf16x8 __attribute__((ext_vector_type(8)));
typedef short s16x4 __attribute__((ext_vector_type(4)));
typedef float f32x4 __attribute__((ext_vector_type(4)));
typedef unsigned u32x4 __attribute__((ext_vector_type(4)));
typedef unsigned u32x2 __attribute__((ext_vector_type(2)));

constexpr int NTOK = 32768, DM = 1024, SEQ = 4096, NBATCH = 8, DEPTH = 4;
constexpr int IN_W = 3364;
constexpr int SC_Q = 0, SC_CKV = 512, SC_QI = 640, SC_KI = 768, SC_WI = 800, SC_POOL = 804, SC_GA = 1316, SC_GB = 2340;
constexpr int PM_LD = 3584;
constexpr int PC_Q = 0, PC_POOL = 512, PC_CKV = 1024, PC_GA = 1280, PC_GB = 2304, PC_QI = 3328, PC_KI = 3456, PC_WI = 3488;
constexpr int IDX_LD = 256;
constexpr int NEXP = 32, TOPK = 4, DFF = 512;
constexpr int NASG = NTOK * TOPK;
constexpr int NROWS = NASG + NEXP * 256;
constexpr int MAXTILES = NROWS / 256;
constexpr float RMS_EPS = 1e-6f;
constexpr float LOG2E = 1.4426950408889634f;

constexpr size_t MiB = 1u << 20;
constexpr size_t WS_CTL = 0, CTL_BYTES = 1 * MiB;
constexpr size_t WS_ADA = 1 * MiB;
constexpr size_t WS_W = 2 * MiB, WL_BYTES = 110 * MiB;
constexpr size_t WO_INMAIN = 0, WO_INPREC = 6 * MiB + 512 * 1024, WO_WA = 8 * MiB, WO_WB = 9 * MiB, WO_WOUT = 10 * MiB, WO_WRP = 12 * MiB,
                 WO_WUK = 13 * MiB + 512 * 1024, WO_WUV = WO_WUK + 128 * 1024, WO_WPOOL = WO_WUV + 128 * 1024, WO_WGU = 14 * MiB, WO_WDN = 78 * MiB;
constexpr size_t WS_X = 442 * MiB, WS_X1 = 570 * MiB, WS_HC = 698 * MiB, WS_IDXP = 826 * MiB, WS_CKVN = 858 * MiB, WS_KIH = 866 * MiB, WS_KIL = 868 * MiB,
                 WS_OAB = 870 * MiB, WS_RT = 934 * MiB, WS_XS = 938 * MiB, WS_ACT = 1210 * MiB, WS_YS = 1346 * MiB, WS_END = 1618 * MiB;
constexpr size_t WS_T1 = WS_XS;
constexpr size_t WS_MG = WS_ACT;
constexpr size_t WS_P = WS_YS;
static_assert((size_t)NTOK * PM_LD * 2 <= 272 * MiB && (size_t)NROWS * 1024 * 2 <= 272 * MiB && (size_t)NROWS * 512 * 2 <= 136 * MiB, "ws map");
constexpr int CW_BAR = 4096;
constexpr int CW_MOE = 8192, CW_MOE_STRIDE = 1024;
constexpr int RING_BYTES = 131072;
constexpr int QL_OFF = RING_BYTES, IDXL_OFF = QL_OFF + 16384, MISC_OFF = 162816;
constexpr int LDS_BYTES = MISC_OFF + 1024;
constexpr int NWAVES = 8, NTHREADS = 512;

typedef float f32x2_t __attribute__((ext_vector_type(2))); typedef __bf16 bf16x2_t __attribute__((ext_vector_type(2)));
__device__ __forceinline__ unsigned pk2(float lo, float hi) { f32x2_t v = {lo, hi}; bf16x2_t b = __builtin_convertvector(v, bf16x2_t); return __builtin_bit_cast(unsigned, b); }
__device__ __forceinline__ unsigned f2bf(float f) { return pk2(f, f) & 0xffffu; }
__device__ __forceinline__ float bf2f(unsigned b) { return __builtin_bit_cast(float, b << 16); }
__device__ __forceinline__ float dpp_f(float v, const int ctrl_sel) {
    const int x = __builtin_bit_cast(int, v);
    int r;
    if (ctrl_sel == 0) r = __builtin_amdgcn_update_dpp(0, x, 0xB1, 0xF, 0xF, true);
    else if (ctrl_sel == 1) r = __builtin_amdgcn_update_dpp(0, x, 0x4E, 0xF, 0xF, true);
    else if (ctrl_sel == 2) r = __builtin_amdgcn_update_dpp(0, x, 0x141, 0xF, 0xF, true);
    else r = __builtin_amdgcn_update_dpp(0, x, 0x140, 0xF, 0xF, true);
    return __builtin_bit_cast(float, r);
}
__device__ __forceinline__ float wave_sum(float v) {
    v += dpp_f(v, 0); v += dpp_f(v, 1); v += dpp_f(v, 2); v += dpp_f(v, 3);
    const int x = __builtin_bit_cast(int, v);
    const float r0 = __builtin_bit_cast(float, __builtin_amdgcn_readlane(x, 0)), r1 = __builtin_bit_cast(float, __builtin_amdgcn_readlane(x, 16)),
                r2 = __builtin_bit_cast(float, __builtin_amdgcn_readlane(x, 32)), r3 = __builtin_bit_cast(float, __builtin_amdgcn_readlane(x, 48));
    return (r0 + r1) + (r2 + r3);
}
__device__ __forceinline__ float shfl_xor_f(float v, int m, int lane) { return __builtin_bit_cast(float, __builtin_amdgcn_ds_bpermute((lane ^ m) << 2, __builtin_bit_cast(int, v))); }
__device__ __forceinline__ unsigned wave_sum_u32(unsigned v) {
    int s = (int)v;
    s += __builtin_amdgcn_update_dpp(0, s, 0xB1, 0xF, 0xF, true);
    s += __builtin_amdgcn_update_dpp(0, s, 0x4E, 0xF, 0xF, true);
    s += __builtin_amdgcn_update_dpp(0, s, 0x141, 0xF, 0xF, true);
    s += __builtin_amdgcn_update_dpp(0, s, 0x140, 0xF, 0xF, true);
    s += __builtin_amdgcn_update_dpp(0, s, 0x142, 0xA, 0xF, false);
    s += __builtin_amdgcn_update_dpp(0, s, 0x143, 0xC, 0xF, false);
    return (unsigned)__builtin_amdgcn_readlane(s, 63);
}
__device__ __forceinline__ unsigned wave_max_u32(unsigned v) {
    unsigned t;
    t = (unsigned)__builtin_amdgcn_update_dpp(0, (int)v, 0xB1, 0xF, 0xF, true); v = v > t ? v : t;
    t = (unsigned)__builtin_amdgcn_update_dpp(0, (int)v, 0x4E, 0xF, 0xF, true); v = v > t ? v : t;
    t = (unsigned)__builtin_amdgcn_update_dpp(0, (int)v, 0x141, 0xF, 0xF, true); v = v > t ? v : t;
    t = (unsigned)__builtin_amdgcn_update_dpp(0, (int)v, 0x140, 0xF, 0xF, true); v = v > t ? v : t;
    const unsigned r0 = (unsigned)__builtin_amdgcn_readlane((int)v, 0), r1 = (unsigned)__builtin_amdgcn_readlane((int)v, 16), r2 = (unsigned)__builtin_amdgcn_readlane((int)v, 32), r3 = (unsigned)__builtin_amdgcn_readlane((int)v, 48);
    const unsigned a = r0 > r1 ? r0 : r1, b = r2 > r3 ? r2 : r3; return a > b ? a : b;
}
__device__ __forceinline__ int fresh_lane() { int l; asm volatile("v_mbcnt_lo_u32_b32 %0, -1, 0\n\tv_mbcnt_hi_u32_b32 %0, -1, %0" : "=v"(l)); return l; }
__device__ __forceinline__ float relu_i(float v) { const int b = __builtin_bit_cast(int, v); return __builtin_bit_cast(float, b > 0 ? b : 0); }
__device__ __forceinline__ float sigmoidf_fast(float v) { return __builtin_amdgcn_rcpf(1.f + __builtin_amdgcn_exp2f(-v * LOG2E)); }

#define XB_TMO      128
#define XB_XCNT(j)  (256  + 64 * (j))
#define XB_XSUB(j)  (1280 + 64 * (j))
#define XB_XGEN(j)  (2304 + 64 * (j))
#define XB_TOP      3328
#define XB_TOPGEN   3392
#define XCD_BAR_WORDS 3456
#define XB_SPIN_CAP (1u << 20)
__device__ __forceinline__ unsigned xb_ld(unsigned* p)              { return __hip_atomic_load(p, __ATOMIC_RELAXED, __HIP_MEMORY_SCOPE_AGENT); }
__device__ __forceinline__ unsigned xb_add(unsigned* p, unsigned v) { return __hip_atomic_fetch_add(p, v, __ATOMIC_RELAXED, __HIP_MEMORY_SCOPE_AGENT); }
__device__ __forceinline__ unsigned xb_xcc_id() { return (unsigned)__builtin_amdgcn_s_getreg((3 << 11) | 20) & 0xFu; }
#define XB_SPIN(cond, bar) do { unsigned _sp = 0; while (cond) { __builtin_amdgcn_s_sleep(1); \
    if ((++_sp & 255u) == 0u) { if (xb_ld(&(bar)[XB_TMO])) break; if (_sp > XB_SPIN_CAP) { atomicAdd(&(bar)[XB_TMO], 1u); break; } } } } while (0)
struct XcdBarrier { unsigned* bar; unsigned x; volatile LAS unsigned* st; };
__device__ __forceinline__ XcdBarrier xcd_barrier_post(unsigned* bar, volatile LAS unsigned* st) {
    XcdBarrier b; b.bar = bar; b.x = xb_xcc_id(); b.st = st;
    if (threadIdx.x == 0) (void)xb_add(&bar[XB_XCNT(b.x)], 1u);
    return b;
}
__device__ __forceinline__ void xcd_barrier_complete(unsigned* bar, unsigned x, unsigned& nloc, unsigned& nx) {
    const unsigned G = gridDim.x * gridDim.y * gridDim.z;
    unsigned sum, cnt, mine, sp = 0u;
    for (;;) {
        sum = 0u; cnt = 0u; mine = 0u;
#pragma unroll
        for (unsigned j = 0; j < 16; ++j) { const unsigned c = xb_ld(&bar[XB_XCNT(j)]); sum += c; cnt += (c > 0u) ? 1u : 0u; mine = (j == x) ? c : mine; }
        if (sum == G) break;
        __builtin_amdgcn_s_sleep(1);
        if ((++sp & 255u) == 0u) { if (xb_ld(&bar[XB_TMO])) break; if (sp > XB_SPIN_CAP) { atomicAdd(&bar[XB_TMO], 1u); break; } }
    }
    nloc = mine > 0u ? mine : 1u; nx = cnt > 0u ? cnt : 1u;
}
__device__ __forceinline__ void xcd_barrier(const XcdBarrier& b) {
    asm volatile("s_waitcnt vmcnt(0)" ::: "memory");
    __syncthreads();
    if (threadIdx.x == 0) {
        unsigned* bar = b.bar; asm volatile("" : "+s"(bar));
        __builtin_amdgcn_s_waitcnt(0);
        unsigned nloc = b.st[0], nx = b.st[1];
        if (nloc == 0u) { xcd_barrier_complete(bar, b.x, nloc, nx); b.st[0] = nloc; b.st[1] = nx; }
        const unsigned old = xb_add(&bar[XB_XSUB(b.x)], 1u);
        const unsigned gen = old / nloc;
        if (old + 1u == (gen + 1u) * nloc) {
            __builtin_amdgcn_fence(__ATOMIC_RELEASE, "agent");
            asm volatile("s_waitcnt vmcnt(0)" ::: "memory");
            const unsigned og = xb_add(&bar[XB_TOP], 1u);
            const unsigned tg = og / nx;
            if (og + 1u == (tg + 1u) * nx) xb_add(&bar[XB_TOPGEN], 1u);
            else XB_SPIN(xb_ld(&bar[XB_TOPGEN]) == tg, bar);
            __builtin_amdgcn_fence(__ATOMIC_ACQUIRE, "agent");
            xb_add(&bar[XB_XGEN(b.x)], 1u);
            asm volatile("s_waitcnt vmcnt(0)" ::: "memory");
        } else {
            XB_SPIN(xb_ld(&bar[XB_XGEN(b.x)]) == gen, bar);
            __builtin_amdgcn_fence(__ATOMIC_ACQUIRE, "agent");
            asm volatile("s_waitcnt vmcnt(0)" ::: "memory");
        }
    }
    __syncthreads();
}

namespace pg8 {
constexpr int BM = 256, BK = 64, HALF = 128, HTB = HALF * BK * 2, NXCD = 8, WGM = 8;
__host__ __device__ __forceinline__ int lds_byte(int r, int c) { const int st = (r >> 4) * 2 + (c >> 5), rr = r & 15, cc = c & 31, ob = rr * 64 + cc * 2; return st * 1024 + (ob ^ (((ob >> 9) & 1) << 5)); }
__host__ __device__ __forceinline__ void stage_rc(int b, int& R, int& C) { const int st = b / 1024, sb = b % 1024, swz = sb ^ (((sb >> 9) & 1) << 5); R = (st >> 1) * 16 + swz / 64; C = (st & 1) * 32 + (swz % 64) / 2; }
__host__ __device__ __forceinline__ int perm32(int rho) { const int n = rho >> 4, i = rho & 15; return 8 * (i >> 2) + 4 * n + (i & 3); }

struct Unit { int pm, pn, pb; };
struct Gemm { const bf16_t* A; const bf16_t* Bt; int lda, ldb, K, kmaskA; const int* perm; };

struct StaticOrder {
    int nN, nwg, c, full;
    __device__ void init(int M, int N, int G_, int c_, int full_ = 1 << 20) { nN = N / BM; nwg = (M / BM) * nN; c = c_; full = full_; (void)G_; }
    __device__ bool next(int i, Unit& u) const {
        if (c < 0) return false;
        int L;
        if (i < full) L = i * 256 + c; else { if (c >= 128) return false; L = full * 256 + (i - full) * 128 + c; }
        if (L >= nwg) return false;
        const int q = nwg >> 3, wgid = (L & 7) * q + (L >> 3);
        const int nig = WGM * nN, gid = wgid / nig, rem = wgid - gid * nig;
        u.pm = gid * WGM + (rem & 7); u.pn = rem >> 3; u.pb = u.pn; return true;
    }
};
struct GroupedOrder {
    const int* tile_e; int T, G, c;
    __device__ bool next(int i, Unit& u) const {
        const int L = i * G + c; if (L >= 4 * T) return false;
        u.pm = L >> 2; u.pn = L & 3; u.pb = tile_e[u.pm] * 4 + u.pn; return true;
    }
};

template <class Epi, class Sched, bool GATHER = false>
__device__ __forceinline__ void gemm_phase(LAS unsigned char* lds, const Gemm g, const Sched& S, const Epi& E, const int wid) {
    const int lane = fresh_lane(), tid = wid * 64 + lane;
    const int wr = wid >> 2, wc = wid & 3, fr = lane & 15, fq = lane >> 4;
    const int K = g.K, nt = K / BK;
    int Rr[2], Cc[2];
    unsigned voB[2], voA[2][2], voAn[2][2];
#pragma unroll
    for (int i = 0; i < 2; ++i) { int R, C; stage_rc(tid * 16 + i * 8192, R, C); Rr[i] = R; Cc[i] = C; const int Rb = Epi::PERM ? ((R & ~31) + perm32(R & 31)) : R;
        voB[i] = (unsigned)(Rb * g.ldb + C) * 2u;
#pragma unroll
        for (int h = 0; h < 2; ++h) { voA[h][i] = (unsigned)((R + HALF * h) * g.lda + C) * 2u; voAn[h][i] = voA[h][i]; } }
    const unsigned kstep = (unsigned)(BK * 2);
    const unsigned hstepB = (unsigned)HALF * g.ldb * 2u, hstepA = (unsigned)HALF * g.lda * 2u;
    const unsigned tstepA = 2u * hstepA, tstepB = 2u * hstepB;
    const __amdgpu_buffer_rsrc_t rA = __builtin_amdgcn_make_buffer_rsrc((void*)g.A, (short)0, 0x7fffffff, 0x00020000);
    const __amdgpu_buffer_rsrc_t rB = __builtin_amdgcn_make_buffer_rsrc((void*)g.Bt, (short)0, 0x7fffffff, 0x00020000);
    const int kmA = g.kmaskA;
    const unsigned ldsw = (unsigned)wid * 1024u;
    const int aoff = lds_byte(wr * 64 + fr, fq * 8), boff = lds_byte(wc * 32 + fr, fq * 8);
#define PG8_SA(b, h) (((b) * 2 + (h)) * HTB)
#define PG8_SB(b, h) ((4 + (b) * 2 + (h)) * HTB)
#define PG8_STAGE2(bufoff, rsrc, soff, o0, o1) do { \
        __builtin_amdgcn_raw_ptr_buffer_load_lds(rsrc, (LAS unsigned*)(lds + (bufoff) + ldsw), 16, (int)(o0), (int)(soff), 0, 0); \
        __builtin_amdgcn_raw_ptr_buffer_load_lds(rsrc, (LAS unsigned*)(lds + (bufoff) + ldsw + 8192), 16, (int)(o1), (int)(soff), 0, 0); } while (0)
#define PG8_STB(b, h, bo) PG8_STAGE2(PG8_SB(b, h), rB, (bo) + ((h) ? hstepB : 0u), voB[0], voB[1])
#define PG8_STA(b, h, ao, VO) do { if constexpr (GATHER) PG8_STAGE2(PG8_SA(b, h), rA, (ao), VO[h][0], VO[h][1]); else PG8_STAGE2(PG8_SA(b, h), rA, (ao) + ((h) ? hstepA : 0u), VO[0][0], VO[0][1]); } while (0)
#define PG8_STAX(b, h, ao) do { const unsigned _o0 = last ? voAn[h][0] : voA[h][0], _o1 = last ? voAn[h][1] : voA[h][1]; PG8_STAGE2(PG8_SA(b, h), rA, (ao), _o0, _o1); } while (0)
#define PG8_LDA(dst, b, h) do { _Pragma("unroll") for (int m = 0; m < 4; ++m) _Pragma("unroll") for (int k = 0; k < 2; ++k) dst[m][k] = *(const LAS bf16x8*)(lds + PG8_SA(b, h) + aoff + m * 2048 + k * 1024); } while (0)
#define PG8_LDB(dst, b, h) do { _Pragma("unroll") for (int n = 0; n < 2; ++n) _Pragma("unroll") for (int k = 0; k < 2; ++k) dst[n][k] = *(const LAS bf16x8*)(lds + PG8_SB(b, h) + boff + n * 2048 + k * 1024); } while (0)
#define PG8_MMA(ai, bj, At, Bt) do { __builtin_amdgcn_s_setprio(1); _Pragma("unroll") for (int m = 0; m < 4; ++m) _Pragma("unroll") for (int n = 0; n < 2; ++n) _Pragma("unroll") for (int k = 0; k < 2; ++k) \
        acc[ai][bj][m][n] = __builtin_amdgcn_mfma_f32_16x16x32_bf16(Bt[n][k], At[m][k], acc[ai][bj][m][n], 0, 0, 0); __builtin_amdgcn_s_setprio(0); } while (0)
#define PG8_WAIT_V(n) asm volatile("s_waitcnt vmcnt(" #n ")" ::: "memory")
#define PG8_WAIT_L(n) asm volatile("s_waitcnt lgkmcnt(0)" ::: "memory")
#define PG8_BAR __builtin_amdgcn_s_barrier()
#define PG8_SCHED __builtin_amdgcn_sched_barrier(0)
#define PG8_KA(tt) (cA + (unsigned)((((tt) * BK) & kmA)) * 2u)
#define PG8_GOFF(VO, pmx) do { _Pragma("unroll") for (int _h = 0; _h < 2; ++_h) _Pragma("unroll") for (int _i = 0; _i < 2; ++_i) \
        VO[_h][_i] = (unsigned)(g.perm[(pmx) * BM + HALF * _h + Rr[_i]] * g.lda + Cc[_i]) * 2u; } while (0)
    Unit cur, nxt; int ui = 0;
    if (!S.next(0, cur)) return;
    f32x4 acc[2][2][4][2];
    f32x4 bnx[2][2];
#pragma unroll
    for (int b = 0; b < 2; ++b)
#pragma unroll
        for (int n = 0; n < 2; ++n) bnx[b][n] = (f32x4){0.f, 0.f, 0.f, 0.f};
    if constexpr (Epi::HAS_BIAS) E.bias(cur, wc, bnx);
#pragma unroll
    for (int a = 0; a < 2; ++a)
#pragma unroll
        for (int b = 0; b < 2; ++b)
#pragma unroll
            for (int m = 0; m < 4; ++m)
#pragma unroll
                for (int n = 0; n < 2; ++n) acc[a][b][m][n] = bnx[b][n];
    bf16x8 At[4][2], B0[2][2], B1[2][2];
    if constexpr (GATHER) PG8_GOFF(voA, cur.pm);
    unsigned cA = GATHER ? 0u : (unsigned)cur.pm * tstepA, cB = (unsigned)cur.pb * tstepB;
    PG8_STB(0, 0, cB); PG8_STB(0, 1, cB); PG8_STA(0, 0, cA, voA); PG8_STA(0, 1, cA, voA);
    if (wr == 1) PG8_BAR;
    PG8_WAIT_V(2); PG8_BAR;
    PG8_STB(1, 0, cB + kstep); PG8_STA(1, 0, cA + kstep, voA); PG8_STB(1, 1, cB + kstep);
    PG8_WAIT_V(6); PG8_BAR;
    for (;;) {
        const bool has_next = S.next(ui + 1, nxt);
        if constexpr (GATHER) { if (has_next) PG8_GOFF(voAn, nxt.pm); }
        const unsigned nA = GATHER ? cA : (has_next ? (unsigned)nxt.pm * tstepA : cA), nB = has_next ? (unsigned)nxt.pb * tstepB : cB;
        for (int t = 0; t < nt; t += 2) {
            if constexpr (Epi::HAS_MID) { if (t == (nt >> 1)) E.mid(acc, cur, wr, wc); }
            const bool last = (t == nt - 2) && (GATHER ? has_next : true);
            const bool lastp = (t == nt - 2);
            const unsigned a1 = PG8_KA(t + 1);
            const unsigned a2 = lastp ? nA : PG8_KA(t + 2), b2 = lastp ? nB : cB + (unsigned)(t + 2) * kstep;
            const unsigned a3 = lastp ? nA + kstep : PG8_KA(t + 3), b3 = b2 + kstep;
            PG8_LDB(B0, 0, 0); PG8_LDB(B1, 0, 1); PG8_SCHED; PG8_LDA(At, 0, 0); PG8_STA(1, 1, a1, voA);
            PG8_WAIT_V(8); PG8_WAIT_L(0); PG8_BAR; PG8_MMA(0, 0, At, B0); PG8_MMA(0, 1, At, B1); PG8_BAR; PG8_SCHED;
            PG8_LDA(At, 0, 1); PG8_STB(0, 0, b2); PG8_STB(0, 1, b2);
            if constexpr (GATHER) PG8_STAX(0, 0, a2); else PG8_STA(0, 0, a2, voA);
            PG8_WAIT_V(8); PG8_WAIT_L(0); PG8_BAR; PG8_MMA(1, 0, At, B0); PG8_MMA(1, 1, At, B1); PG8_BAR; PG8_SCHED;
            PG8_LDB(B0, 1, 0); PG8_LDB(B1, 1, 1); PG8_SCHED; PG8_LDA(At, 1, 0);
            if constexpr (GATHER) PG8_STAX(0, 1, a2); else PG8_STA(0, 1, a2, voA);
            PG8_WAIT_V(8); PG8_WAIT_L(0); PG8_BAR; PG8_MMA(0, 0, At, B0); PG8_MMA(0, 1, At, B1); PG8_BAR; PG8_SCHED;
            PG8_LDA(At, 1, 1); PG8_STB(1, 0, b3); PG8_STB(1, 1, b3);
            if constexpr (GATHER) PG8_STAX(1, 0, a3); else PG8_STA(1, 0, a3, voA);
            PG8_WAIT_V(8); PG8_WAIT_L(0); PG8_BAR; PG8_MMA(1, 0, At, B0); PG8_MMA(1, 1, At, B1); PG8_BAR; PG8_SCHED;
        }
        if (wr == 0) PG8_BAR;
        if constexpr (Epi::HAS_BIAS) { if (has_next) E.bias(nxt, wc, bnx); }
        E(acc, cur, wr, wc, fr, fq);
        if (!has_next) break;
#pragma unroll
        for (int a = 0; a < 2; ++a)
#pragma unroll
            for (int b = 0; b < 2; ++b)
#pragma unroll
                for (int m = 0; m < 4; ++m)
#pragma unroll
                    for (int n = 0; n < 2; ++n) acc[a][b][m][n] = bnx[b][n];
        cur = nxt; cA = nA; cB = nB; ++ui;
        if constexpr (GATHER) {
#pragma unroll
            for (int h = 0; h < 2; ++h)
#pragma unroll
                for (int i = 0; i < 2; ++i) voA[h][i] = voAn[h][i]; }
        if (wr == 1) PG8_BAR;
    }
    PG8_WAIT_V(0);
    PG8_BAR;
#undef PG8_SA
#undef PG8_SB
#undef PG8_STAGE2
#undef PG8_STB
#undef PG8_STA
#undef PG8_STAX
#undef PG8_LDA
#undef PG8_LDB
#undef PG8_MMA
#undef PG8_WAIT_V
#undef PG8_WAIT_L
#undef PG8_BAR
#undef PG8_SCHED
#undef PG8_KA
#undef PG8_GOFF
}

typedef f32x4 Acc[2][2][4][2];
struct EpiInMain {
    static constexpr bool PERM = true, HAS_MID = false, HAS_BIAS = false;
    bf16_t* P;
    __device__ __forceinline__ void operator()(const Acc& acc, const Unit& u, int wr, int wc, int, int) const {
        const int l2 = fresh_lane(), fr = l2 & 15, fq = l2 >> 4;
        const int row0 = u.pm * BM + wr * 64 + fr, col0 = u.pn * BM + wc * 32 + 8 * fq; const bool sg = u.pn >= 5 && u.pn < 13;
#pragma unroll
        for (int ai = 0; ai < 2; ++ai)
#pragma unroll
            for (int m = 0; m < 4; ++m) { bf16_t* rowp = P + (size_t)(row0 + ai * HALF + m * 16) * PM_LD + col0;
#pragma unroll
                for (int bj = 0; bj < 2; ++bj) { f32x4 v0 = acc[ai][bj][m][0], v1 = acc[ai][bj][m][1];
                    if (sg) {
#pragma unroll
                        for (int i = 0; i < 4; ++i) { v0[i] = sigmoidf_fast(v0[i]); v1[i] = sigmoidf_fast(v1[i]); } }
                    u32x4 o; o.x = pk2(v0[0], v0[1]); o.y = pk2(v0[2], v0[3]); o.z = pk2(v1[0], v1[1]); o.w = pk2(v1[2], v1[3]);
                    *(u32x4*)(rowp + bj * HALF) = o; } }
    }
};
struct EpiF32 {
    static constexpr bool PERM = false, HAS_MID = false, HAS_BIAS = false;
    float* C; int ldc;
    __device__ __forceinline__ void operator()(const Acc& acc, const Unit& u, int wr, int wc, int, int) const {
        const int l2 = fresh_lane(), fr = l2 & 15, fq = l2 >> 4;
        const int row0 = u.pm * BM + wr * 64 + fr, col0 = u.pn * BM + wc * 32 + 4 * fq;
#pragma unroll
        for (int ai = 0; ai < 2; ++ai)
#pragma unroll
            for (int m = 0; m < 4; ++m) { float* rowp = C + (size_t)(row0 + ai * HALF + m * 16) * ldc + col0;
#pragma unroll
                for (int bj = 0; bj < 2; ++bj)
#pragma unroll
                    for (int n = 0; n < 2; ++n) *(f32x4*)(rowp + bj * HALF + n * 16) = acc[ai][bj][m][n]; }
    }
};
struct EpiGateA {
    static constexpr bool PERM = false, HAS_MID = false, HAS_BIAS = false;
    float* T1; const bf16_t* P;
    __device__ __forceinline__ void operator()(const Acc& acc, const Unit& u, int wr, int wc, int, int) const {
        const int l2 = fresh_lane(), fr = l2 & 15, fq = l2 >> 4;
        const int row0 = u.pm * BM + wr * 64 + fr, col0 = u.pn * BM + wc * 32 + 4 * fq;
#pragma unroll
        for (int ai = 0; ai < 2; ++ai)
#pragma unroll
            for (int m = 0; m < 4; ++m) { const size_t row = (size_t)(row0 + ai * HALF + m * 16);
#pragma unroll
                for (int bj = 0; bj < 2; ++bj)
#pragma unroll
                    for (int n = 0; n < 2; ++n) { const int c = col0 + bj * HALF + n * 16;
                        const u32x2 gp = *(const u32x2*)(P + row * PM_LD + PC_GA + c);
                        f32x4 v = acc[ai][bj][m][n];
                        v[0] *= bf2f(gp.x & 0xffffu); v[1] *= bf2f(gp.x >> 16); v[2] *= bf2f(gp.y & 0xffffu); v[3] *= bf2f(gp.y >> 16);
                        *(f32x4*)(T1 + row * 1024 + c) = v; }
                asm volatile("" ::: "memory"); }
    }
};
struct EpiGateB {
    static constexpr bool PERM = true, HAS_MID = false, HAS_BIAS = false;
    bf16_t* MG; const float* T1; const bf16_t* P;
    __device__ __forceinline__ void operator()(const Acc& acc, const Unit& u, int wr, int wc, int, int) const {
        const int l2 = fresh_lane(), fr = l2 & 15, fq = l2 >> 4;
        const int row0 = u.pm * BM + wr * 64 + fr, col0 = u.pn * BM + wc * 32 + 8 * fq;
#pragma unroll
        for (int ai = 0; ai < 2; ++ai)
#pragma unroll
            for (int m = 0; m < 4; ++m) { const size_t row = (size_t)(row0 + ai * HALF + m * 16);
#pragma unroll
                for (int bj = 0; bj < 2; ++bj) { const int c = col0 + bj * HALF;
                    const u32x4 gp = *(const u32x4*)(P + row * PM_LD + PC_GB + c);
                    const f32x4 t0 = *(const f32x4*)(T1 + row * 1024 + c), t1 = *(const f32x4*)(T1 + row * 1024 + c + 4);
                    const f32x4 a0 = acc[ai][bj][m][0], a1 = acc[ai][bj][m][1];
                    u32x4 o;
                    o.x = pk2(t0[0] + bf2f(gp.x & 0xffffu) * a0[0], t0[1] + bf2f(gp.x >> 16) * a0[1]);
                    o.y = pk2(t0[2] + bf2f(gp.y & 0xffffu) * a0[2], t0[3] + bf2f(gp.y >> 16) * a0[3]);
                    o.z = pk2(t1[0] + bf2f(gp.z & 0xffffu) * a1[0], t1[1] + bf2f(gp.z >> 16) * a1[1]);
                    o.w = pk2(t1[2] + bf2f(gp.w & 0xffffu) * a1[2], t1[3] + bf2f(gp.w >> 16) * a1[3]);
                    *(u32x4*)(MG + row * 1024 + c) = o; }
                asm volatile("" ::: "memory"); }
    }
};
struct EpiGate {
    static constexpr bool PERM = true, HAS_MID = true, HAS_BIAS = false;
    bf16_t* MG; const bf16_t* P;
    __device__ __forceinline__ void mid(Acc& acc, const Unit& u, int wr, int wc) const {
        const int l2 = fresh_lane(), fr = l2 & 15, fq = l2 >> 4;
        const int row0 = u.pm * BM + wr * 64 + fr, col0 = u.pn * BM + wc * 32 + 8 * fq;
#pragma unroll
        for (int ai = 0; ai < 2; ++ai) {
            u32x4 ga[4][2], gb[4][2];
#pragma unroll
            for (int m = 0; m < 4; ++m)
#pragma unroll
                for (int bj = 0; bj < 2; ++bj) { const bf16_t* gp = P + (size_t)(row0 + ai * HALF + m * 16) * PM_LD + col0 + bj * HALF;
                    ga[m][bj] = *(const u32x4*)(gp + PC_GA); gb[m][bj] = *(const u32x4*)(gp + PC_GB); }
#pragma unroll
            for (int m = 0; m < 4; ++m)
#pragma unroll
                for (int bj = 0; bj < 2; ++bj) { const u32x4 a = ga[m][bj], g = gb[m][bj];
                    f32x4& a0 = acc[ai][bj][m][0]; f32x4& a1 = acc[ai][bj][m][1];
                    a0[0] *= bf2f(a.x & 0xffffu) * __builtin_amdgcn_rcpf(bf2f(g.x & 0xffffu)); a0[1] *= bf2f(a.x >> 16) * __builtin_amdgcn_rcpf(bf2f(g.x >> 16));
                    a0[2] *= bf2f(a.y & 0xffffu) * __builtin_amdgcn_rcpf(bf2f(g.y & 0xffffu)); a0[3] *= bf2f(a.y >> 16) * __builtin_amdgcn_rcpf(bf2f(g.y >> 16));
                    a1[0] *= bf2f(a.z & 0xffffu) * __builtin_amdgcn_rcpf(bf2f(g.z & 0xffffu)); a1[1] *= bf2f(a.z >> 16) * __builtin_amdgcn_rcpf(bf2f(g.z >> 16));
                    a1[2] *= bf2f(a.w & 0xffffu) * __builtin_amdgcn_rcpf(bf2f(g.w & 0xffffu)); a1[3] *= bf2f(a.w >> 16) * __builtin_amdgcn_rcpf(bf2f(g.w >> 16)); }
            asm volatile("" ::: "memory"); }
    }
    __device__ __forceinline__ void operator()(const Acc& acc, const Unit& u, int wr, int wc, int, int) const {
        const int l2 = fresh_lane(), fr = l2 & 15, fq = l2 >> 4;
        const int row0 = u.pm * BM + wr * 64 + fr, col0 = u.pn * BM + wc * 32 + 8 * fq;
#pragma unroll
        for (int ai = 0; ai < 2; ++ai) {
            u32x4 gb[4][2];
#pragma unroll
            for (int m = 0; m < 4; ++m)
#pragma unroll
                for (int bj = 0; bj < 2; ++bj) gb[m][bj] = *(const u32x4*)(P + (size_t)(row0 + ai * HALF + m * 16) * PM_LD + PC_GB + col0 + bj * HALF);
#pragma unroll
            for (int m = 0; m < 4; ++m)
#pragma unroll
                for (int bj = 0; bj < 2; ++bj) { const u32x4 g = gb[m][bj];
                    const f32x4 a0 = acc[ai][bj][m][0], a1 = acc[ai][bj][m][1];
                    u32x4 o;
                    o.x = pk2(bf2f(g.x & 0xffffu) * a0[0], bf2f(g.x >> 16) * a0[1]); o.y = pk2(bf2f(g.y & 0xffffu) * a0[2], bf2f(g.y >> 16) * a0[3]);
                    o.z = pk2(bf2f(g.z & 0xffffu) * a1[0], bf2f(g.z >> 16) * a1[1]); o.w = pk2(bf2f(g.w & 0xffffu) * a1[2], bf2f(g.w >> 16) * a1[3]);
                    *(u32x4*)(MG + (size_t)(row0 + ai * HALF + m * 16) * 1024 + col0 + bj * HALF) = o; }
            asm volatile("" ::: "memory"); }
    }
};
template <bool XA_BF16> struct EpiWout {
    static constexpr bool PERM = true, HAS_MID = false, HAS_BIAS = false;
    bf16_t* X1; const void* XA; const float* g1;
    __device__ __forceinline__ void operator()(const Acc& acc, const Unit& u, int wr, int wc, int, int) const {
        const int l2 = fresh_lane(), fr = l2 & 15, fq = l2 >> 4;
        const int row0 = u.pm * BM + wr * 64 + fr, col0 = u.pn * BM + wc * 32 + 8 * fq;
        const float* gb = g1 + (size_t)((u.pm * BM) / SEQ) * 6144;
        bf16_t* __restrict__ X1 = this->X1; const void* __restrict__ XA = this->XA;
#pragma unroll
        for (int bj = 0; bj < 2; ++bj) { const int c = col0 + bj * HALF;
            const f32x4 g0 = *(const f32x4*)(gb + c), g1v = *(const f32x4*)(gb + c + 4);
#pragma unroll
            for (int ai = 0; ai < 2; ++ai)
#pragma unroll
                for (int m = 0; m < 4; ++m) { const size_t row = (size_t)(row0 + ai * HALF + m * 16);
                    f32x4 x0, x1;
                    if constexpr (XA_BF16) { const u32x4 xb = *(const u32x4*)((const bf16_t*)XA + row * 1024 + c);
                        x0 = (f32x4){bf2f(xb.x & 0xffffu), bf2f(xb.x >> 16), bf2f(xb.y & 0xffffu), bf2f(xb.y >> 16)}; x1 = (f32x4){bf2f(xb.z & 0xffffu), bf2f(xb.z >> 16), bf2f(xb.w & 0xffffu), bf2f(xb.w >> 16)}; }
                    else { x0 = *(const f32x4*)((const float*)XA + row * 1024 + c); x1 = *(const f32x4*)((const float*)XA + row * 1024 + c + 4); }
                    const f32x4 v0 = x0 + g0 * acc[ai][bj][m][0], v1 = x1 + g1v * acc[ai][bj][m][1];
                    u32x4 o; o.x = pk2(v0[0], v0[1]); o.y = pk2(v0[2], v0[3]); o.z = pk2(v1[0], v1[1]); o.w = pk2(v1[2], v1[3]);
                    *(u32x4*)(X1 + row * 1024 + c) = o; } }
    }
};
struct EpiGU {
    static constexpr bool PERM = true, HAS_MID = false, HAS_BIAS = true;
    bf16_t* ACT; const float* bgu;
    __device__ __forceinline__ void bias(const Unit& u, int wc, f32x4 (&bv)[2][2]) const {
        const int fq = fresh_lane() >> 4; const int cl = wc * 32 + 8 * fq, e = u.pb >> 2;
        const float* bg = bgu + (size_t)e * 1024 + u.pn * 128 + cl;
        bv[0][0] = *(const f32x4*)bg; bv[0][1] = *(const f32x4*)(bg + 4); bv[1][0] = *(const f32x4*)(bg + 512); bv[1][1] = *(const f32x4*)(bg + 516);
    }
    __device__ __forceinline__ void operator()(const Acc& acc, const Unit& u, int wr, int wc, int, int) const {
        const int l2 = fresh_lane(), fr = l2 & 15, fq = l2 >> 4;
        const int row0 = u.pm * BM + wr * 64 + fr, cl = wc * 32 + 8 * fq;
        const f32x4 bg0 = (f32x4){0.f, 0.f, 0.f, 0.f}, bg1 = bg0, bu0 = bg0, bu1 = bg0;
#pragma unroll
        for (int ai = 0; ai < 2; ++ai)
#pragma unroll
            for (int m = 0; m < 4; ++m) { const size_t row = (size_t)(row0 + ai * HALF + m * 16);
                float r[8];
#pragma unroll
                for (int i = 0; i < 4; ++i) {
                    float g0 = acc[ai][0][m][0][i] + bg0[i], u0 = acc[ai][1][m][0][i] + bu0[i];
                    float g1 = acc[ai][0][m][1][i] + bg1[i], u1 = acc[ai][1][m][1][i] + bu1[i];
                    g0 = fminf(g0, 7.f); u0 = fminf(fmaxf(u0, -7.f), 7.f); g1 = fminf(g1, 7.f); u1 = fminf(fmaxf(u1, -7.f), 7.f);
                    r[i] = g0 * sigmoidf_fast(1.702f * g0) * (u0 + 1.f); r[4 + i] = g1 * sigmoidf_fast(1.702f * g1) * (u1 + 1.f); }
                u32x4 o; o.x = pk2(r[0], r[1]); o.y = pk2(r[2], r[3]); o.z = pk2(r[4], r[5]); o.w = pk2(r[6], r[7]);
                *(u32x4*)(ACT + row * 512 + u.pn * 128 + cl) = o; }
    }
};
struct EpiDown {
    static constexpr bool PERM = true, HAS_MID = false, HAS_BIAS = true;
    bf16_t* YS; const float* bdn;
    __device__ __forceinline__ void bias(const Unit& u, int wc, f32x4 (&bv)[2][2]) const {
        const int fq = fresh_lane() >> 4; const int col0 = u.pn * BM + wc * 32 + 8 * fq, e = u.pb >> 2;
        const float* bp = bdn + (size_t)e * 1024 + col0;
#pragma unroll
        for (int bj = 0; bj < 2; ++bj) { bv[bj][0] = *(const f32x4*)(bp + bj * HALF); bv[bj][1] = *(const f32x4*)(bp + bj * HALF + 4); }
    }
    __device__ __forceinline__ void operator()(const Acc& acc, const Unit& u, int wr, int wc, int, int) const {
        const int l2 = fresh_lane(), fr = l2 & 15, fq = l2 >> 4;
        const int row0 = u.pm * BM + wr * 64 + fr, col0 = u.pn * BM + wc * 32 + 8 * fq;
#pragma unroll
        for (int bj = 0; bj < 2; ++bj) {
            const f32x4 b0 = (f32x4){0.f, 0.f, 0.f, 0.f}, b1 = b0;
#pragma unroll
            for (int ai = 0; ai < 2; ++ai)
#pragma unroll
                for (int m = 0; m < 4; ++m) { bf16_t* rowp = YS + (size_t)(row0 + ai * HALF + m * 16) * 1024 + col0 + bj * HALF;
                    const f32x4 v0 = acc[ai][bj][m][0] + b0, v1 = acc[ai][bj][m][1] + b1;
                    u32x4 o; o.x = pk2(v0[0], v0[1]); o.y = pk2(v0[2], v0[3]); o.z = pk2(v1[0], v1[1]); o.w = pk2(v1[2], v1[3]);
                    *(u32x4*)rowp = o; }
            asm volatile("" ::: "memory"); }
    }
};
}

struct Args { const float* in[22]; float* out; unsigned char* ws; int ph_lo, ph_hi, use_bar, pad; };
struct Frame {
    LAS unsigned char* lds; volatile LAS unsigned* MISC;
    int wave, vcu, G, gw, NGW;
    GAS unsigned char* ws; GAS unsigned* ctl;
};
enum { I_X = 0, I_C, I_N1G, I_N2G, I_WADA, I_BADA, I_WIN, I_KVG, I_WUK, I_WUV, I_WPOOL, I_PSCALE, I_WAUP, I_WBUP, I_WOUT, I_WR, I_BR, I_WGU, I_BGU, I_WDN, I_BDN, I_FG };

struct TJob { const float* src; int ld_src, scol0, nvalid, nwrite, K; bf16_t* dst; int ld_dst, drow0, mode; };
__device__ __forceinline__ void tr_tile(const TJob& J, int k0, int n0, LAS float* scr, int lane) {
    if (n0 + 64 <= J.nvalid) {
#pragma unroll 8
        for (int i = 0; i < 16; ++i) {
            const int kk = 4 * i + (lane >> 4), nc = (lane & 15) * 4;
            const f32x4 v = *(const f32x4*)(J.src + (size_t)(k0 + kk) * J.ld_src + J.scol0 + n0 + nc);
            scr[kk * 65 + nc + 0] = v[0]; scr[kk * 65 + nc + 1] = v[1]; scr[kk * 65 + nc + 2] = v[2]; scr[kk * 65 + nc + 3] = v[3];
        }
    } else {
#pragma unroll 4
        for (int i = 0; i < 16; ++i) {
            const int kk = 4 * i + (lane >> 4), nc = (lane & 15) * 4;
            f32x4 v = (f32x4){0.f, 0.f, 0.f, 0.f};
            if (n0 + nc < J.nvalid) v = *(const f32x4*)(J.src + (size_t)(k0 + kk) * J.ld_src + J.scol0 + n0 + nc);
            scr[kk * 65 + nc + 0] = v[0]; scr[kk * 65 + nc + 1] = v[1]; scr[kk * 65 + nc + 2] = v[2]; scr[kk * 65 + nc + 3] = v[3];
        }
    }
    asm volatile("s_waitcnt lgkmcnt(0)" ::: "memory");
    const int c = lane & 7;
#pragma unroll
    for (int j = 0; j < 8; ++j) {
        const int n = j * 8 + (lane >> 3);
        float v[8];
#pragma unroll
        for (int q = 0; q < 8; ++q) v[q] = scr[(8 * c + q) * 65 + n];
        if (n0 + n < J.nwrite) {
            bf16_t* d = J.dst + (size_t)(J.drow0 + n0 + n) * J.ld_dst + k0 + 8 * c;
            u32x4 hi; hi.x = pk2(v[0], v[1]); hi.y = pk2(v[2], v[3]); hi.z = pk2(v[4], v[5]); hi.w = pk2(v[6], v[7]);
            *(u32x4*)d = hi;
            if (J.mode == 2) {
                float r[8];
#pragma unroll
                for (int q = 0; q < 8; ++q) r[q] = v[q] - bf2f(f2bf(v[q]));
                u32x4 lo; lo.x = pk2(r[0], r[1]); lo.y = pk2(r[2], r[3]); lo.z = pk2(r[4], r[5]); lo.w = pk2(r[6], r[7]);
                *(u32x4*)(d + 1024) = hi; *(u32x4*)(d + 2048) = lo;
            }
        }
    }
    asm volatile("s_waitcnt lgkmcnt(0)" ::: "memory");
}
constexpr int TJ_ITEMS_LAYER = 128 + 128 + 64 + 256 + 256 + 32 + 16 + 32 + 128 + 128 + 256 + 64 + 16 + 16 + 8192 + 4096;
__device__ __forceinline__ void tj_decode(const Args& a, int it, TJob& J, int& k0, int& n0) {
    const int l = it / TJ_ITEMS_LAYER; int r = it % TJ_ITEMS_LAYER;
    unsigned char* wl = a.ws + WS_W + (size_t)l * WL_BYTES;
    const float* win = a.in[I_WIN] + (size_t)l * DM * IN_W;
    int ntn;
#define TJ_SET(SRC, LDS_, SC0, NV, NW, KK, DST, LDD, DR0, MD) { J.src = (SRC); J.ld_src = (LDS_); J.scol0 = (SC0); J.nvalid = (NV); J.nwrite = (NW); J.K = (KK); J.dst = (bf16_t*)(DST); J.ld_dst = (LDD); J.drow0 = (DR0); J.mode = (MD); ntn = ((NW) + 63) / 64; }
    if (r < 128) TJ_SET(win, IN_W, SC_Q, 512, 512, 1024, wl + WO_INMAIN, 1024, PC_Q, 0)
    else if ((r -= 128) < 128) TJ_SET(win, IN_W, SC_POOL, 512, 512, 1024, wl + WO_INMAIN, 1024, PC_POOL, 0)
    else if ((r -= 128) < 64) TJ_SET(win, IN_W, SC_CKV, 128, 256, 1024, wl + WO_INMAIN, 1024, PC_CKV, 0)
    else if ((r -= 64) < 256) TJ_SET(win, IN_W, SC_GA, 1024, 1024, 1024, wl + WO_INMAIN, 1024, PC_GA, 0)
    else if ((r -= 256) < 256) TJ_SET(win, IN_W, SC_GB, 1024, 1024, 1024, wl + WO_INMAIN, 1024, PC_GB, 0)
    else if ((r -= 256) < 32) TJ_SET(win, IN_W, SC_QI, 128, 128, 1024, wl + WO_INMAIN, 1024, PC_QI, 0)
    else if ((r -= 32) < 16) TJ_SET(win, IN_W, SC_KI, 32, 32, 1024, wl + WO_INMAIN, 1024, PC_KI, 0)
    else if ((r -= 16) < 32) TJ_SET(win, IN_W, SC_WI, 4, 96, 1024, wl + WO_INMAIN, 1024, PC_WI, 0)
    else if ((r -= 32) < 128) TJ_SET(a.in[I_WAUP] + (size_t)l * 512 * 1024, 1024, 0, 1024, 1024, 512, wl + WO_WA, 1024, 0, 0)
    else if ((r -= 128) < 128) TJ_SET(a.in[I_WBUP] + (size_t)l * 512 * 1024, 1024, 0, 1024, 1024, 512, wl + WO_WA + 1024, 1024, 0, 0)
    else if ((r -= 128) < 256) TJ_SET(a.in[I_WOUT] + (size_t)l * 1024 * 1024, 1024, 0, 1024, 1024, 1024, wl + WO_WOUT, 1024, 0, 0)
    else if ((r -= 256) < 64) TJ_SET(a.in[I_WR] + (size_t)l * 1024 * 32, 32, 0, 32, 256, 1024, wl + WO_WRP, 3072, 0, 2)
    else if ((r -= 64) < 16) TJ_SET(a.in[I_WUV] + (size_t)l * 128 * 512, 512, 0, 512, 512, 128, wl + WO_WUV, 128, 0, 0)
    else if ((r -= 16) < 16) { const int g = r >> 2; r &= 3; TJ_SET(a.in[I_WPOOL] + ((size_t)l * 4 + g) * 128 * 128, 128, 0, 128, 128, 128, wl + WO_WPOOL + (size_t)g * 128 * 128 * 2, 128, 0, 0) }
    else if ((r -= 16) < 8192) { const int e = r >> 8, j = (r >> 5) & 7, pn = j >> 1, half = j & 1; r &= 31;
        TJ_SET(a.in[I_WGU] + ((size_t)l * 32 + e) * 1024 * 1024, 1024, half * 512 + pn * 128, 128, 128, 1024, wl + WO_WGU + (size_t)e * 1024 * 1024 * 2, 1024, pn * 256 + half * 128, 0) }
    else { r -= 8192; const int e = r >> 7; r &= 127;
        TJ_SET(a.in[I_WDN] + ((size_t)l * 32 + e) * 512 * 1024, 1024, 0, 1024, 1024, 512, wl + WO_WDN + (size_t)e * 1024 * 512 * 2, 512, 0, 0) }
#undef TJ_SET
    k0 = (r / ntn) * 64; n0 = (r % ntn) * 64;
}
__device__ __forceinline__ void phase_prologue(const Args& a, Frame& F) {
    const int plane = fresh_lane(), ptid = F.wave * 64 + plane;
    {
        LAS float* cond = (LAS float*)F.lds;
        LAS float* red = (LAS float*)(F.lds + 32768);
        for (int i = ptid; i < 8 * 1024; i += NTHREADS) { const float c = a.in[I_C][i]; cond[i] = c / (1.f + __expf(-c)); }
        __syncthreads();
        const int cs = ptid & 63, ks = ptid >> 6;
        for (int it = F.vcu; it < DEPTH * 96; it += F.G) {
            const int l = it / 96, col = (it % 96) * 64 + cs;
            const float* w = a.in[I_WADA] + (size_t)l * 1024 * 6144 + (size_t)(ks * 128) * 6144 + col;
            float acc[8] = {0, 0, 0, 0, 0, 0, 0, 0};
#pragma unroll 32
            for (int k = 0; k < 128; ++k) { const float wv = w[(size_t)k * 6144];
#pragma unroll
                for (int b = 0; b < 8; ++b) acc[b] += cond[b * 1024 + ks * 128 + k] * wv; }
#pragma unroll
            for (int b = 0; b < 8; ++b) red[(ks * 8 + b) * 64 + cs] = acc[b];
            __syncthreads();
            { const int b = ptid >> 6; float s = 0.f;
#pragma unroll
              for (int k2 = 0; k2 < 8; ++k2) s += red[(k2 * 8 + b) * 64 + cs];
              ((float*)(a.ws + WS_ADA))[((size_t)l * 8 + b) * 6144 + col] = s + a.in[I_BADA][(size_t)l * 6144 + col]; }
            __syncthreads();
        }
    }
    {
        LAS float* scr = (LAS float*)(F.lds + F.wave * 16640);
        for (int it = F.gw; it < DEPTH * TJ_ITEMS_LAYER; it += F.NGW) {
            TJob J; int k0, n0; tj_decode(a, it, J, k0, n0);
            tr_tile(J, k0, n0, scr, plane);
        }
        for (int i = F.gw * 64 + plane; i < DEPTH * 128 * 512 / 4; i += F.NGW * 64) {
            const int l = i / (128 * 128), r = i % (128 * 128), lat = r / 128, hd = (r % 128) * 4, h = hd >> 6, d = hd & 63;
            const f32x4 v = *(const f32x4*)(a.in[I_WUK] + (size_t)l * 128 * 512 + lat * 512 + hd);
            u32x2 o; o.x = pk2(v[0], v[1]); o.y = pk2(v[2], v[3]);
            *(u32x2*)((bf16_t*)(a.ws + WS_W + (size_t)l * WL_BYTES + WO_WUK) + (h * 128 + lat) * 64 + d) = o;
        }
    }
}

__device__ __forceinline__ void store_hilo(bf16_t* hc_row, int lane, const f32x4 (&h)[4]) {
#pragma unroll
    for (int j = 0; j < 4; ++j) {
        const unsigned h0 = f2bf(h[j][0]), h1 = f2bf(h[j][1]), h2 = f2bf(h[j][2]), h3 = f2bf(h[j][3]);
        u32x2 hi; hi.x = h0 | (h1 << 16); hi.y = h2 | (h3 << 16);
        *(u32x2*)(hc_row + 4 * lane + 256 * j) = hi;
    }
}
__device__ __forceinline__ void norm_mod_row(const f32x4 (&v)[4], int lane, const float* gam, const float* sc, const float* sh, bf16_t* hc_row) {
    float ss = 0.f;
#pragma unroll
    for (int j = 0; j < 4; ++j) ss += (v[j][0] * v[j][0] + v[j][1] * v[j][1]) + (v[j][2] * v[j][2] + v[j][3] * v[j][3]);
    const float rstd = 1.0f / sqrtf(wave_sum(ss) * (1.f / DM) + RMS_EPS);
    f32x4 h[4];
#pragma unroll
    for (int j = 0; j < 4; ++j) { const int c = 4 * lane + 256 * j;
        const f32x4 g = *(const f32x4*)(gam + c), s1 = *(const f32x4*)(sc + c), s0 = *(const f32x4*)(sh + c);
        h[j] = (v[j] * rstd * g) * (s1 + 1.f) + s0; }
    store_hilo(hc_row, lane, h);
}
__device__ __forceinline__ void phase_norm(Frame& F, const float* X, const float* gam, const float* ada_l, int off_sh, int off_sc) {
    bf16_t* HC = (bf16_t*)(F.ws + WS_HC);
    const int lane = fresh_lane();
    for (int row = F.gw; row < NTOK; row += F.NGW) {
        const f32x4* xr = (const f32x4*)(X + (size_t)row * DM) + lane;
        f32x4 v[4];
#pragma unroll
        for (int j = 0; j < 4; ++j) v[j] = xr[64 * j];
        const float* ab = ada_l + (size_t)(row / SEQ) * 6144;
        norm_mod_row(v, lane, gam, ab + off_sc, ab + off_sh, HC + (size_t)row * 1024);
    }
}

template <int G>
__device__ __forceinline__ void pool_group(const bf16_t* __restrict__ P, const LAS unsigned char* wl, const float* __restrict__ pscale, bf16_t* __restrict__ OAB, int tile, int fr, int fq, LAS unsigned char* st) {
    constexpr int W = 2 << G;
    const int tok0 = tile * 16, tok = tok0 + fr, t = tok % SEQ;
    const int nwin = (t + 1 < W) ? t + 1 : W;
    const float inv = 1.f / (float)nwin;
    { const int lane = fq * 16 + fr, bstart = tok0 - (tok0 % SEQ);
#pragma unroll
      for (int i = 0; i < (15 + W + 3) / 4; ++i) { const int j = lane + 64 * i, r = (16 - W) + (j >> 4), ch = j & 15;
        if (r < 31) { int srow = tok0 - 15 + r; srow = srow < bstart ? bstart : srow;
            const u32x4 v = *(const u32x4*)(P + (size_t)srow * PM_LD + PC_POOL + G * 128 + ch * 8);
            *(LAS u32x4*)(st + r * 272 + ch * 16) = v; } } }
    bf16x8 Af[4];
#pragma unroll
    for (int kk = 0; kk < 4; ++kk) {
        const LAS unsigned char* base = st + (fr + 15) * 272 + (4 * kk + fq) * 16;
        float s[8] = {0, 0, 0, 0, 0, 0, 0, 0};
        u32x4 sv = (u32x4){0u, 0u, 0u, 0u};
#pragma unroll
        for (int d = 0; d < W; ++d) { const float mk = (d < nwin) ? 1.f : 0.f; const u32x4 p = *(const LAS u32x4*)(base - d * 272);
            if (d == 0) sv = p;
            s[0] += mk * bf2f(p.x & 0xffffu); s[1] += mk * bf2f(p.x >> 16); s[2] += mk * bf2f(p.y & 0xffffu); s[3] += mk * bf2f(p.y >> 16);
            s[4] += mk * bf2f(p.z & 0xffffu); s[5] += mk * bf2f(p.z >> 16); s[6] += mk * bf2f(p.w & 0xffffu); s[7] += mk * bf2f(p.w >> 16); }
        u32x4 o; o.x = pk2(s[0] * inv - bf2f(sv.x & 0xffffu), s[1] * inv - bf2f(sv.x >> 16)); o.y = pk2(s[2] * inv - bf2f(sv.y & 0xffffu), s[3] * inv - bf2f(sv.y >> 16));
        o.z = pk2(s[4] * inv - bf2f(sv.z & 0xffffu), s[5] * inv - bf2f(sv.z >> 16)); o.w = pk2(s[6] * inv - bf2f(sv.w & 0xffffu), s[7] * inv - bf2f(sv.w >> 16));
        Af[kk] = __builtin_bit_cast(bf16x8, o);
    }
#pragma unroll 1
    for (int nh = 0; nh < 2; ++nh) {
        bf16x8 Bf[4][4];
#pragma unroll
        for (int n4 = 0; n4 < 4; ++n4)
#pragma unroll
            for (int kk = 0; kk < 4; ++kk) Bf[n4][kk] = *(const LAS bf16x8*)(wl + ((nh * 4 + n4) * 16 + fr) * 272 + (4 * kk + fq) * 16);
        f32x4 psv[4];
#pragma unroll
        for (int n4 = 0; n4 < 4; ++n4) psv[n4] = *(const LAS f32x4*)(wl + 34816 + (G * 128 + (nh * 4 + n4) * 16 + 4 * fq) * 4);
#pragma unroll
        for (int n4 = 0; n4 < 4; ++n4) { const int nt = nh * 4 + n4;
            f32x4 c = (f32x4){0.f, 0.f, 0.f, 0.f};
#pragma unroll
            for (int kk = 0; kk < 4; ++kk) c = __builtin_amdgcn_mfma_f32_16x16x32_bf16(Bf[n4][kk], Af[kk], c, 0, 0, 0);
            const int dcol = G * 128 + nt * 16 + 4 * fq; const f32x4 ps = psv[n4];
            u32x2 w2; w2.x = pk2(c[0] * ps[0], c[1] * ps[1]); w2.y = pk2(c[2] * ps[2], c[3] * ps[3]);
            *(u32x2*)(OAB + (size_t)(tile * 16 + fr) * 1024 + 512 + dcol) = w2;
        }
    }
}
__device__ __forceinline__ void phase_prep(const Args& a, Frame& F, int l) {
    const bf16_t* P = (const bf16_t*)(F.ws + WS_P);
    bf16_t* CKVN = (bf16_t*)(F.ws + WS_CKVN); bf16_t* KI = (bf16_t*)(F.ws + WS_KIH);
    const float* kvg = a.in[I_KVG] + (size_t)l * 128;
    const int lane = fresh_lane(), fr = lane & 15, fq = lane >> 4;
    { f32x4 kg0 = *(const f32x4*)(kvg + 8 * fr), kg1 = *(const f32x4*)(kvg + 8 * fr + 4);
      for (int r4 = F.gw; r4 < NTOK / 4; r4 += F.NGW) {
        const size_t row = (size_t)r4 * 4 + fq;
        const u32x4 cp = *(const u32x4*)(P + row * PM_LD + PC_CKV + 8 * fr);
        float c[8] = {bf2f(cp.x & 0xffffu), bf2f(cp.x >> 16), bf2f(cp.y & 0xffffu), bf2f(cp.y >> 16), bf2f(cp.z & 0xffffu), bf2f(cp.z >> 16), bf2f(cp.w & 0xffffu), bf2f(cp.w >> 16)};
        float ss = (c[0] * c[0] + c[1] * c[1]) + (c[2] * c[2] + c[3] * c[3]) + (c[4] * c[4] + c[5] * c[5]) + (c[6] * c[6] + c[7] * c[7]);
        ss += dpp_f(ss, 0); ss += dpp_f(ss, 1); ss += dpp_f(ss, 2); ss += dpp_f(ss, 3);
        const float rstd = 1.0f / sqrtf(ss * (1.f / 128.f) + RMS_EPS);
        u32x4 o; o.x = pk2(c[0] * rstd * kg0[0], c[1] * rstd * kg0[1]); o.y = pk2(c[2] * rstd * kg0[2], c[3] * rstd * kg0[3]);
        o.z = pk2(c[4] * rstd * kg1[0], c[5] * rstd * kg1[1]); o.w = pk2(c[6] * rstd * kg1[2], c[7] * rstd * kg1[3]);
        *(u32x4*)(CKVN + row * 128 + 8 * fr) = o;
        if (fr < 4) *(u32x4*)(KI + row * 32 + 8 * fr) = *(const u32x4*)(P + row * PM_LD + PC_KI + 8 * fr);
      } }
    bf16_t* OAB = (bf16_t*)(F.ws + WS_OAB);
    const bf16_t* WP = (const bf16_t*)(F.ws + WS_W + (size_t)l * WL_BYTES + WO_WPOOL);
    const float* pscale = a.in[I_PSCALE] + (size_t)l * 512;
    { const int tid = F.wave * 64 + lane; const int tile = F.gw;
      LAS unsigned char* st = F.lds + 36864 + F.wave * 8704;
      static_assert(NTOK / 16 == 256 * NWAVES, "one pooling tile per wave");
      if (tid < 128) *(LAS f32x4*)(F.lds + 34816 + tid * 16) = *(const f32x4*)(pscale + tid * 4);
#define POOL_G(G) do { __syncthreads(); { u32x4 wv[4]; \
          _Pragma("unroll") for (int i = 0; i < 4; ++i) { const int c = tid + NTHREADS * i; wv[i] = *(const u32x4*)(WP + (size_t)(G) * 128 * 128 + (size_t)c * 8); } \
          _Pragma("unroll") for (int i = 0; i < 4; ++i) { const int c = tid + NTHREADS * i; *(LAS u32x4*)(F.lds + (c >> 4) * 272 + (c & 15) * 16) = wv[i]; } } \
          __syncthreads(); pool_group<G>(P, F.lds, pscale, OAB, tile, fr, fq, st); } while (0)
      POOL_G(0); POOL_G(1); POOL_G(2); POOL_G(3);
#undef POOL_G
      __syncthreads(); }
}

__device__ __forceinline__ unsigned gimg_off(int row, int ch) { return 256u * row + 16u * (ch ^ (((row & 3) << 2) | ((row >> 2) & 3))); }
__device__ __forceinline__ s16x4 lds_tr16(LAS unsigned char* p) { typedef short v4s __attribute__((ext_vector_type(4))); return __builtin_bit_cast(s16x4, __builtin_amdgcn_ds_read_tr16_b64_v4i16((LAS v4s*)p)); }

__device__ __forceinline__ void phase_attention(const Args& a, Frame& F, int l) {
    const bf16_t* P = (const bf16_t*)(F.ws + WS_P);
    const float* IDXP = (const float*)(F.ws + WS_IDXP);
    const bf16_t* CKVN = (const bf16_t*)(F.ws + WS_CKVN); const bf16_t* KIH = (const bf16_t*)(F.ws + WS_KIH); const bf16_t* KIL = (const bf16_t*)(F.ws + WS_KIL);
    bf16_t* OAB = (bf16_t*)(F.ws + WS_OAB);
    const bf16_t* WUK = (const bf16_t*)(F.ws + WS_W + (size_t)l * WL_BYTES + WO_WUK);
    const bf16_t* WUV = (const bf16_t*)(F.ws + WS_W + (size_t)l * WL_BYTES + WO_WUV);
    const int lane = fresh_lane();
    const int wave = F.wave, fr = lane & 15, fq = lane >> 4;
    constexpr int SCROW = 4112;
    LAS float* SC = (LAS float*)F.lds;
    LAS unsigned char* myreg = F.lds + wave * (SCROW * 4);
    LAS unsigned short* IDXL0 = (LAS unsigned short*)(F.lds + IDXL_OFF) + wave * 256;
    LAS unsigned short* IDXL1 = (LAS unsigned short*)(F.lds + QL_OFF + 1024) + wave * 256;
    bf16_t* QLG = (bf16_t*)(F.ws + WS_XS) + (size_t)F.vcu * 128 * 1024;
    bf16_t* OLG = (bf16_t*)(F.ws + WS_XS + 64 * MiB) + (size_t)F.vcu * 128 * 1024;
#define TOK_OF(qi) ((size_t)((qi) >> 4) * SEQ + (size_t)((((qi) >> 3) & 1) ? (511 - F.vcu) : F.vcu) * 8 + ((qi) & 7))
    if (wave >= 4) __builtin_amdgcn_s_setprio(1);
    {
        const int h = wave;
        bf16x8 Bk[8][2];
#pragma unroll
        for (int nt = 0; nt < 8; ++nt)
#pragma unroll
            for (int kk = 0; kk < 2; ++kk) Bk[nt][kk] = *(const bf16x8*)(WUK + ((size_t)h * 128 + nt * 16 + fr) * 64 + 32 * kk + 8 * fq);
#pragma unroll 1
        for (int mb = 0; mb < 2; ++mb) {
        bf16x8 Aqa[4][2];
#pragma unroll
        for (int m4 = 0; m4 < 4; ++m4) { const int qi = 16 * (4 * mb + m4) + fr;
            const bf16_t* qp = P + TOK_OF(qi) * PM_LD + PC_Q + h * 64 + 8 * fq;
            Aqa[m4][0] = *(const bf16x8*)qp; Aqa[m4][1] = *(const bf16x8*)(qp + 32); }
#pragma unroll
        for (int m4 = 0; m4 < 4; ++m4) {
            const int mt = 4 * mb + m4;
            const int qi = 16 * mt + fr;
            const bf16x8 Aq0 = Aqa[m4][0], Aq1 = Aqa[m4][1];
#pragma unroll
            for (int nt = 0; nt < 8; ++nt) {
                f32x4 c = (f32x4){0.f, 0.f, 0.f, 0.f};
                c = __builtin_amdgcn_mfma_f32_16x16x32_bf16(Bk[nt][0], Aq0, c, 0, 0, 0);
                c = __builtin_amdgcn_mfma_f32_16x16x32_bf16(Bk[nt][1], Aq1, c, 0, 0, 0);
                u32x2 w2; w2.x = pk2(c[0] * (0.125f * LOG2E), c[1] * (0.125f * LOG2E)); w2.y = pk2(c[2] * (0.125f * LOG2E), c[3] * (0.125f * LOG2E));
                *(u32x2*)(QLG + ((size_t)qi * 8 + h) * 128 + 16 * nt + 4 * fq) = w2;
            }
        }
        }
        asm volatile("s_waitcnt vmcnt(0)" ::: "memory");
    }
    __syncthreads();
#define UNIT_PARAMS(half) const int ui = 2 * b + (half); const int pb = (half) ? (511 - F.vcu) : F.vcu; \
        const int t0 = pb * 8;                             \
        const size_t tok0 = (size_t)b * SEQ + t0; \
        const bool do_select = (t0 >= 256);                \
        const int roff = (half) ? 0 : (SCROW - 16 * ((t0 + 8 + 15) >> 4)); (void)ui; (void)tok0; (void)roff
#pragma unroll 1
    for (int b = 0; b < 8; ++b) {
        u32x4 qvp[2][2]; unsigned wvp[2][2]; u32x2 wpp[2][2];
#pragma unroll
        for (int hf = 0; hf < 2; ++hf)
#pragma unroll
            for (int g = 0; g < 2; ++g) { const size_t tk = (size_t)b * SEQ + (size_t)(hf ? (511 - F.vcu) : F.vcu) * 8 + g * 4;
                const bf16_t* ip = P + (tk + (fr >> 2)) * PM_LD;
                wvp[hf][g] = ip[PC_WI + (fr & 3)]; qvp[hf][g] = *(const u32x4*)(ip + PC_QI + (fr & 3) * 32 + 8 * fq);
                wpp[hf][g] = *(const u32x2*)(P + (tk + fq) * PM_LD + PC_WI); }
        __syncthreads();
#pragma unroll 1
        for (int half = 0; half < 2; ++half) {
        UNIT_PARAMS(half);
        if (do_select) {
            bf16x8 Aq[2]; float sg[2][4];
#pragma unroll
            for (int g = 0; g < 2; ++g) {
                const float wv = fabsf(bf2f(half ? wvp[1][g] : wvp[0][g]));
                const u32x4 qv = half ? qvp[1][g] : qvp[0][g];
                u32x4 H; H.x = pk2(bf2f(qv.x & 0xffffu) * wv, bf2f(qv.x >> 16) * wv); H.y = pk2(bf2f(qv.y & 0xffffu) * wv, bf2f(qv.y >> 16) * wv);
                H.z = pk2(bf2f(qv.z & 0xffffu) * wv, bf2f(qv.z >> 16) * wv); H.w = pk2(bf2f(qv.w & 0xffffu) * wv, bf2f(qv.w >> 16) * wv);
                Aq[g] = __builtin_bit_cast(bf16x8, H);
                const u32x2 wp2 = half ? wpp[1][g] : wpp[0][g];
                sg[g][0] = (wp2.x & 0x8000u) ? -1.f : 1.f; sg[g][1] = (wp2.x & 0x80000000u) ? -1.f : 1.f; sg[g][2] = (wp2.y & 0x8000u) ? -1.f : 1.f; sg[g][3] = (wp2.y & 0x80000000u) ? -1.f : 1.f;
            }
            const int nT = (t0 + 8 + 15) >> 4;
            const int cnt = (nT - wave + 7) >> 3;
            const bf16_t* kbase = KIH + ((size_t)b * SEQ + fr) * 32 + 8 * fq;
#define SCORE_TILE(T, BH) do { _Pragma("unroll") for (int g = 0; g < 2; ++g) { f32x4 c = (f32x4){0.f, 0.f, 0.f, 0.f}; \
                    c = __builtin_amdgcn_mfma_f32_16x16x32_bf16(Aq[g], BH, c, 0, 0, 0); \
                    const float sc1 = (sg[g][0] * relu_i(c[0]) + sg[g][1] * relu_i(c[1])) + (sg[g][2] * relu_i(c[2]) + sg[g][3] * relu_i(c[3])); \
                    SC[(g * 4 + fq) * SCROW + roff + 16 * (T) + fr] = sc1 + 0.0f; } } while (0)
            int i = 0;
#pragma unroll 1
            for (; i + 4 <= cnt; i += 4) {
                const int T = wave + 8 * i;
                bf16x8 bh[4];
#pragma unroll
                for (int j = 0; j < 4; ++j) bh[j] = *(const bf16x8*)(kbase + (size_t)(16 * (T + 8 * j)) * 32);
#pragma unroll
                for (int j = 0; j < 4; ++j) SCORE_TILE(T + 8 * j, bh[j]);
            }
#pragma unroll 1
            for (; i < cnt; ++i) { const int T = wave + 8 * i;
                const bf16x8 bh1 = *(const bf16x8*)(kbase + (size_t)(16 * T) * 32);
                SCORE_TILE(T, bh1); }
#undef SCORE_TILE
        }
        }
        __syncthreads();
#pragma unroll 1
        for (int half = 0; half < 2; ++half) {
        UNIT_PARAMS(half);
        LAS unsigned short* IDXL = half ? IDXL1 : IDXL0;
        const int t = t0 + wave;
        if (do_select) {
            unsigned key[64];
            unsigned kzero = 0u; asm volatile("" : "+v"(kzero));
            const LAS float* myS = SC + wave * SCROW + roff;
            const int nr = (t >> 6) + 1;
            const int nb = (nr + 7) >> 3;
            unsigned thr = 0u, totS = 0u, cgt = 0u;
#define LOADKEYS(NB) do { _Pragma("unroll") for (int r = 0; r < 64; ++r) { unsigned u = kzero; \
                if (r < 8 * (NB)) { const int e = r * 64 + lane; u = __builtin_bit_cast(unsigned, myS[e]); u ^= ((unsigned)((int)u >> 31) | 0x80000000u); if (r >= 8 * ((NB) - 1)) u = (e <= t) ? u : 0u; }     \
                key[r] = u; } } while (0)
#define CNT8(acc, r0, c) do { unsigned long long _t0, _t1, _t2; asm("v_cmp_le_u32 vcc, %12, %4\n\tv_cmp_le_u32_e64 %1, %12, %5\n\tv_cmp_le_u32_e64 %2, %12, %6\n\tv_cmp_le_u32_e64 %3, %12, %7\n\tv_addc_co_u32 %0, vcc, 0, %0, vcc\n\tv_addc_co_u32_e64 %0, %1, 0, %0, %1\n\tv_addc_co_u32_e64 %0, %2, 0, %0, %2\n\tv_addc_co_u32_e64 %0, %3, 0, %0, %3\n\tv_cmp_le_u32 vcc, %12, %8\n\tv_cmp_le_u32_e64 %1, %12, %9\n\tv_cmp_le_u32_e64 %2, %12, %10\n\tv_cmp_le_u32_e64 %3, %12, %11\n\tv_addc_co_u32 %0, vcc, 0, %0, vcc\n\tv_addc_co_u32_e64 %0, %1, 0, %0, %1\n\tv_addc_co_u32_e64 %0, %2, 0, %0, %2\n\tv_addc_co_u32_e64 %0, %3, 0, %0, %3" : "+v"(acc), "=&s"(_t0), "=&s"(_t1), "=&s"(_t2) : "v"(key[r0]), "v"(key[r0 + 1]), "v"(key[r0 + 2]), "v"(key[r0 + 3]), "v"(key[r0 + 4]), "v"(key[r0 + 5]), "v"(key[r0 + 6]), "v"(key[r0 + 7]), "s"(c) : "vcc"); } while (0)
#define CNT32(NB, out, lcout, cnd) do { unsigned _a0 = kzero, _a1 = kzero; const unsigned _c = (cnd); \
                _Pragma("unroll") for (int r8 = 0; r8 < 8 * (NB); r8 += 8) { if ((r8 >> 3) & 1) CNT8(_a1, r8, _c); else CNT8(_a0, r8, _c); } \
                lcout = _a0 + _a1; out = wave_sum_u32(lcout); } while (0)
#define COMPACT4(r0) do { unsigned _a; unsigned long long _t0, _t1, _t2; asm volatile("v_cmp_le_u32 vcc, %12, %6\n\tv_cmp_le_u32_e64 %3, %12, %7\n\tv_cmp_le_u32_e64 %4, %12, %8\n\tv_cmp_le_u32_e64 %5, %12, %9\n\tv_lshl_add_u32 %2, %0, 1, %10\n\tv_cndmask_b32_e64 %2, %11, %2, vcc\n\tv_addc_co_u32_e64 %0, vcc, 0, %0, vcc\n\tds_write_b16 %2, %1\n\tv_add_u32 %1, 64, %1\n\tv_lshl_add_u32 %2, %0, 1, %10\n\tv_cndmask_b32_e64 %2, %11, %2, %3\n\tv_addc_co_u32_e64 %0, %3, 0, %0, %3\n\tds_write_b16 %2, %1\n\tv_add_u32 %1, 64, %1\n\tv_lshl_add_u32 %2, %0, 1, %10\n\tv_cndmask_b32_e64 %2, %11, %2, %4\n\tv_addc_co_u32_e64 %0, %4, 0, %0, %4\n\tds_write_b16 %2, %1\n\tv_add_u32 %1, 64, %1\n\tv_lshl_add_u32 %2, %0, 1, %10\n\tv_cndmask_b32_e64 %2, %11, %2, %5\n\tv_addc_co_u32_e64 %0, %5, 0, %0, %5\n\tds_write_b16 %2, %1\n\tv_add_u32 %1, 64, %1" : "+v"(pos), "+v"(idxv), "=&v"(_a), "=&s"(_t0), "=&s"(_t1), "=&s"(_t2) : "v"(key[r0]), "v"(key[r0 + 1]), "v"(key[r0 + 2]), "v"(key[r0 + 3]), "v"(ibase), "v"(dmy), "s"(thr) : "vcc", "memory"); } while (0)
#define COMPACT_FAST(NB) do { const unsigned cntl = lcS; \
                int sc = (int)cntl; \
                sc += __builtin_amdgcn_update_dpp(0, sc, 0x111, 0xF, 0xF, true); sc += __builtin_amdgcn_update_dpp(0, sc, 0x112, 0xF, 0xF, true); \
                sc += __builtin_amdgcn_update_dpp(0, sc, 0x114, 0xF, 0xF, true); sc += __builtin_amdgcn_update_dpp(0, sc, 0x118, 0xF, 0xF, true);     \
                sc += __builtin_amdgcn_update_dpp(0, sc, 0x142, 0xA, 0xF, false); sc += __builtin_amdgcn_update_dpp(0, sc, 0x143, 0xC, 0xF, false);    \
                unsigned pos = (unsigned)sc - cntl, idxv = (unsigned)lane; \
                const unsigned ibase = (unsigned)(__UINTPTR_TYPE__)IDXL, dmy = (unsigned)(__UINTPTR_TYPE__)(LAS unsigned short*)(F.MISC + 128 + wave); \
                _Pragma("unroll") for (int r = 0; r < 8 * (NB); r += 4) COMPACT4(r); } while (0)
#define SELECT32(NB) do { LOADKEYS(NB); \
                unsigned mxl = kzero; _Pragma("unroll") for (int r = 0; r < 8 * (NB); ++r) mxl = mxl > key[r] ? mxl : key[r]; \
                unsigned mxw = wave_max_u32(mxl); mxw = mxw < 0xfffffffeu ? mxw : 0xfffffffeu; \
                unsigned lo = 0u, hi = mxw + 1u, cLo = 512u * (NB), cHi = 0u, lcS = kzero; \
                if ((NB) >= 3) { _Pragma("unroll 1") for (int nOct = 0; nOct < 6 && cLo != 256u; ++nOct) {     \
                    if (((lo ^ (hi - 1u)) >> 23) == 0u) break; \
                    const unsigned cand = (hi - 1u) & 0xFF800000u; unsigned tot, lc; CNT32(NB, tot, lc, cand); \
                    if (tot >= 256u) { lo = cand; cLo = tot; lcS = lc; } else { hi = cand; cHi = tot; } } } \
                if (cLo != 256u) { _Pragma("unroll 1") for (;;) { const unsigned w = hi - lo; if (w <= 1u) break; \
                    const unsigned cand = lo + (w >> 1); unsigned tot, lc; CNT32(NB, tot, lc, cand); \
                    if (tot >= 256u) { lo = cand; cLo = tot; lcS = lc; if (tot == 256u) break; } else { hi = cand; cHi = tot; } } } \
                thr = lo; totS = cLo; cgt = cHi; \
                if (totS == 256u) COMPACT_FAST(NB); } while (0)
            if (nb <= 4) { if (nb == 1) SELECT32(1); else if (nb == 2) SELECT32(2); else if (nb == 3) SELECT32(3); else SELECT32(4); }
            else { if (nb == 5) SELECT32(5); else if (nb == 6) SELECT32(6); else if (nb == 7) SELECT32(7); else SELECT32(8); }
#undef SELECT32
#undef COMPACT_FAST
#undef COMPACT4
#undef CNT32
#undef CNT8
#undef LOADKEYS
            const int need = 256 - (int)cgt;
            if (totS != 256u) {
            int selb = 0, eqb = 0;
#pragma unroll
            for (int blk = 0; blk < 8; ++blk) if (blk * 8 < nr) {
#pragma unroll
                for (int r8 = 0; r8 < 8; ++r8) { const int r = blk * 8 + r8;
                    const bool gt = key[r] > thr, eq = key[r] == thr;
                    const unsigned long long meq = __ballot(eq);
                    const int eqrank = eqb + (int)__builtin_amdgcn_mbcnt_hi((unsigned)(meq >> 32), __builtin_amdgcn_mbcnt_lo((unsigned)meq, 0u));
                    const bool sel = gt || (eq && eqrank < need);
                    const unsigned long long msel = __ballot(sel);
                    const int pos = selb + (int)__builtin_amdgcn_mbcnt_hi((unsigned)(msel >> 32), __builtin_amdgcn_mbcnt_lo((unsigned)msel, 0u));
                    if (sel && pos < 256) IDXL[pos] = (unsigned short)(r * 64 + lane);
                    selb += __popcll(msel); eqb += __popcll(meq); }
            }
            }
        } else {
#pragma unroll
            for (int j = 0; j < 4; ++j) IDXL[lane + 64 * j] = (unsigned short)(lane + 64 * j);
        }
        }
        asm volatile("s_waitcnt lgkmcnt(0)" ::: "memory");
#pragma unroll 1
        for (int half = 0; half < 2; ++half) {
        UNIT_PARAMS(half);
        LAS unsigned short* IDXL = half ? IDXL1 : IDXL0;
        const int t = t0 + wave;
        const int nsel = (t + 1 < 256) ? t + 1 : 256;
        { const int lane4 = fresh_lane(); const int fr = lane4 & 15, fq = lane4 >> 4, lane = lane4;
        bf16x8 bq[4];
#pragma unroll
        for (int kk = 0; kk < 4; ++kk) {
            u32x4 z = (u32x4){0u, 0u, 0u, 0u};
            if (fr < 8) z = *(const u32x4*)(QLG + ((size_t)(ui * 8 + wave) * 8 + fr) * 128 + 32 * kk + 8 * fq);
            bq[kk] = __builtin_bit_cast(bf16x8, z);
        }
        f32x4 o[8];
#pragma unroll
        for (int mt = 0; mt < 8; ++mt) o[mt] = (f32x4){0.f, 0.f, 0.f, 0.f};
        float mrun = -INFINITY, lsum = 0.f;
        const int nch = (nsel + 31) >> 5;
        const int q4 = fr >> 2, p4 = fr & 3;
        const unsigned swr = (unsigned)(((fr & 3) << 2) | ((fr >> 2) & 3)), swt = (unsigned)((q4 << 2) | fq);
        LAS unsigned char* apA[4]; LAS unsigned char* apT[8];
#pragma unroll
        for (int kk = 0; kk < 4; ++kk) apA[kk] = myreg + 256 * fr + 16 * ((unsigned)(4 * kk + fq) ^ swr);
#pragma unroll
        for (int mt = 0; mt < 8; ++mt) apT[mt] = myreg + 256 * (4 * fq + q4) + 16 * ((unsigned)(2 * mt + (p4 >> 1)) ^ swt) + 8 * (p4 & 1);
        unsigned dsw4[4];
#pragma unroll
        for (int j = 0; j < 4; ++j) dsw4[j] = ((unsigned)fr ^ (unsigned)((fq << 2) | j)) << 4;
        const __amdgpu_buffer_rsrc_t rck = __builtin_amdgcn_make_buffer_rsrc((void*)(CKVN + (size_t)b * SEQ * 128), (short)0, SEQ * 256, 0x00020000);
#define DMA_CHUNK(cc, BUF) do { unsigned rowi[8];     \
            _Pragma("unroll") for (int i = 0; i < 8; ++i) rowi[i] = IDXL[(cc) * 32 + 4 * i + fq]; \
            asm volatile("s_waitcnt lgkmcnt(0)" ::: "memory"); \
            _Pragma("unroll") for (int i = 0; i < 8; ++i) \
            __builtin_amdgcn_raw_ptr_buffer_load_lds(rck, (LAS unsigned*)(myreg + (BUF) * 8192 + i * 1024), 16, (int)(rowi[i] * 256u + dsw4[i & 3]), 0, 0, 0); } while (0)
#define LDS_R128(dst, ptr, off) asm volatile("ds_read_b128 %0, %1 offset:%2" : "=v"(dst) : "v"((unsigned)(__UINTPTR_TYPE__)(ptr)), "n"(off))
#define LDS_TR64(dst, ptr, off) asm volatile("ds_read_b64_tr_b16 %0, %1 offset:%2" : "=v"(dst) : "v"((unsigned)(__UINTPTR_TYPE__)(ptr)), "n"(off))
#define COMPUTE_CHUNK(ch, BUF, MASKED, NCC) do { \
            unsigned rowi_n[8];     \
            if ((NCC) >= 0) { _Pragma("unroll") for (int i = 0; i < 8; ++i) rowi_n[i] = IDXL[((NCC) < 0 ? 0 : (NCC)) * 32 + 4 * i + fq]; } \
            bf16x8 Ak[2][4]; \
            _Pragma("unroll") for (int T = 0; T < 2; ++T) _Pragma("unroll") for (int kk = 0; kk < 4; ++kk) LDS_R128(Ak[T][kk], apA[kk], (BUF) * 8192 + 4096 * T); \
            s16x4 tr0[8], tr1[8]; \
            _Pragma("unroll") for (int mt = 0; mt < 8; ++mt) { LDS_TR64(tr0[mt], apT[mt], (BUF) * 8192); LDS_TR64(tr1[mt], apT[mt], (BUF) * 8192 + 4096); } \
            asm volatile("s_waitcnt lgkmcnt(15)" ::: "memory"); __builtin_amdgcn_sched_barrier(0);     \
            f32x4 s[2]; const float nm = ((ch) == 0) ? 0.f : -mrun;     \
            _Pragma("unroll") for (int T = 0; T < 2; ++T) { s[T] = (f32x4){nm, nm, nm, nm}; \
                _Pragma("unroll") for (int kk = 0; kk < 4; ++kk) s[T] = __builtin_amdgcn_mfma_f32_16x16x32_bf16(Ak[T][kk], bq[kk], s[T], 0, 0, 0); } \
            if (MASKED) { _Pragma("unroll") for (int T = 0; T < 2; ++T) _Pragma("unroll") for (int r = 0; r < 4; ++r) { const int slot = (ch) * 32 + 16 * T + 4 * fq + r; s[T][r] = (slot < nsel) ? s[T][r] : -INFINITY; } } \
            if ((ch) == 0) { float cmax = fmaxf(fmaxf(fmaxf(s[0][0], s[0][1]), fmaxf(s[0][2], s[0][3])), fmaxf(fmaxf(s[1][0], s[1][1]), fmaxf(s[1][2], s[1][3]))); \
                cmax = fmaxf(cmax, shfl_xor_f(cmax, 16, lane)); cmax = fmaxf(cmax, shfl_xor_f(cmax, 32, lane)); mrun = cmax; } \
            _Pragma("unroll") for (int T = 0; T < 2; ++T) _Pragma("unroll") for (int r = 0; r < 4; ++r) { const float p = __builtin_amdgcn_exp2f(((ch) == 0) ? s[T][r] - mrun : s[T][r]); s[T][r] = p; lsum += p; } \
            u32x4 pk; pk.x = pk2(s[0][0], s[0][1]); pk.y = pk2(s[0][2], s[0][3]); pk.z = pk2(s[1][0], s[1][1]); pk.w = pk2(s[1][2], s[1][3]); \
            const bf16x8 Bp = __builtin_bit_cast(bf16x8, pk); \
            asm volatile("s_waitcnt lgkmcnt(0)" ::: "memory"); __builtin_amdgcn_sched_barrier(0); \
            _Pragma("unroll") for (int mt = 0; mt < 4; ++mt) { const bf16x8 Av4 = __builtin_shufflevector(tr0[mt], tr1[mt], 0, 1, 2, 3, 4, 5, 6, 7); \
                o[mt] = __builtin_amdgcn_mfma_f32_16x16x32_bf16(Av4, Bp, o[mt], 0, 0, 0); } \
            if ((NCC) >= 0) { _Pragma("unroll") for (int i = 0; i < 8; ++i)     \
                __builtin_amdgcn_raw_ptr_buffer_load_lds(rck, (LAS unsigned*)(myreg + (BUF) * 8192 + i * 1024), 16, (int)(rowi_n[i] * 256u + dsw4[i & 3]), 0, 0, 0); } \
            _Pragma("unroll") for (int mt = 0; mt < 4; ++mt) { \
                const bf16x8 Av = __builtin_shufflevector(tr0[mt + 4], tr1[mt + 4], 0, 1, 2, 3, 4, 5, 6, 7); \
                o[mt + 4] = __builtin_amdgcn_mfma_f32_16x16x32_bf16(Av, Bp, o[mt + 4], 0, 0, 0); } } while (0)
#define VM_WAIT(n) asm volatile("s_waitcnt vmcnt(" #n ")" ::: "memory")
        if (nsel == 256) {
            DMA_CHUNK(0, 0); DMA_CHUNK(1, 1);
            VM_WAIT(8); COMPUTE_CHUNK(0, 0, false, 2);
            VM_WAIT(8); COMPUTE_CHUNK(1, 1, false, 3);
            VM_WAIT(8); COMPUTE_CHUNK(2, 0, false, 4);
            VM_WAIT(8); COMPUTE_CHUNK(3, 1, false, 5);
            VM_WAIT(8); COMPUTE_CHUNK(4, 0, false, 6);
            VM_WAIT(8); COMPUTE_CHUNK(5, 1, false, 7);
            VM_WAIT(8); COMPUTE_CHUNK(6, 0, false, -1);
            VM_WAIT(0); COMPUTE_CHUNK(7, 1, false, -1);
        } else {
#pragma unroll 1
            for (int ch = 0; ch < nch; ++ch) { DMA_CHUNK(ch, 0); VM_WAIT(0); COMPUTE_CHUNK(ch, 0, true, -1); }
        }
#undef VM_WAIT
#undef DMA_CHUNK
#undef COMPUTE_CHUNK
        lsum += shfl_xor_f(lsum, 16, lane); lsum += shfl_xor_f(lsum, 32, lane);
        const float linv = 1.f / lsum;
        if (fr < 8) {
#pragma unroll
            for (int mt = 0; mt < 8; ++mt) { u32x2 w2; w2.x = pk2(o[mt][0] * linv, o[mt][1] * linv); w2.y = pk2(o[mt][2] * linv, o[mt][3] * linv);
                *(u32x2*)(OLG + ((size_t)(ui * 8 + wave) * 8 + fr) * 128 + 16 * mt + 4 * fq) = w2; }
        }
        }
        }
    }
#undef UNIT_PARAMS
    asm volatile("s_waitcnt vmcnt(0)" ::: "memory");
    __syncthreads();
    {
        const int lane5 = fresh_lane(); const int fr = lane5 & 15, fq = lane5 >> 4;
        const int h = wave;
        bf16x8 Bv[4][4];
#pragma unroll
        for (int nt = 0; nt < 4; ++nt)
#pragma unroll
            for (int kk = 0; kk < 4; ++kk) Bv[nt][kk] = *(const bf16x8*)(WUV + ((size_t)h * 64 + nt * 16 + fr) * 128 + 32 * kk + 8 * fq);
#pragma unroll 1
        for (int mb = 0; mb < 2; ++mb) {
        bf16x8 Aoa[4][4];
#pragma unroll
        for (int m4 = 0; m4 < 4; ++m4) { const int qi = 16 * (4 * mb + m4) + fr;
            const bf16_t* op = OLG + ((size_t)qi * 8 + h) * 128 + 8 * fq;
#pragma unroll
            for (int kk = 0; kk < 4; ++kk) Aoa[m4][kk] = *(const bf16x8*)(op + 32 * kk); }
#pragma unroll
        for (int m4 = 0; m4 < 4; ++m4) {
            const int mt = 4 * mb + m4;
            const int qi = 16 * mt + fr;
            bf16x8 Ao[4];
#pragma unroll
            for (int kk = 0; kk < 4; ++kk) Ao[kk] = Aoa[m4][kk];
            bf16_t* outp = OAB + TOK_OF(qi) * 1024 + h * 64 + 4 * fq;
#pragma unroll
            for (int nt = 0; nt < 4; ++nt) {
                f32x4 c = (f32x4){0.f, 0.f, 0.f, 0.f};
#pragma unroll
                for (int kk = 0; kk < 4; ++kk) c = __builtin_amdgcn_mfma_f32_16x16x32_bf16(Bv[nt][kk], Ao[kk], c, 0, 0, 0);
                u32x2 w2; w2.x = pk2(c[0], c[1]); w2.y = pk2(c[2], c[3]);
                *(u32x2*)(outp + 16 * nt) = w2;
            }
        }
        }
    }
#undef TOK_OF
    __builtin_amdgcn_s_setprio(0);
    __syncthreads();
}

__device__ __forceinline__ void phase_route(const Args& a, Frame& F, int l) {
    const float* LG = (const float*)(F.ws + WS_IDXP);
    int* TOPE = (int*)(F.ws + WS_RT); float* TOPW = (float*)(F.ws + WS_RT + 512 * 1024); int* RANK = (int*)(F.ws + WS_RT + 1024 * 1024);
    unsigned* CNT = (unsigned*)(F.ctl + CW_MOE + l * CW_MOE_STRIDE);
    const float* br = a.in[I_BR] + (size_t)l * 32;
    volatile LAS unsigned* lc = F.MISC + 32;
    const int tid = F.wave * 64 + fresh_lane();
    for (int chunk = F.vcu; chunk < NTOK / NTHREADS; chunk += F.G) {
        if (tid < 32) lc[tid] = 0u;
        __syncthreads();
        const int row = chunk * NTHREADS + tid;
        float v[32];
#pragma unroll
        for (int j = 0; j < 8; ++j) { const f32x4 t4 = *(const f32x4*)(LG + (size_t)row * IDX_LD + 4 * j); const f32x4 b4 = *(const f32x4*)(br + 4 * j);
            v[4 * j] = t4[0] + b4[0]; v[4 * j + 1] = t4[1] + b4[1]; v[4 * j + 2] = t4[2] + b4[2]; v[4 * j + 3] = t4[3] + b4[3]; }
        unsigned taken = 0u; float tv[4]; int te[4];
#pragma unroll
        for (int k = 0; k < 4; ++k) {
            float best = -INFINITY; int bi = 0;
#pragma unroll
            for (int e = 0; e < 32; ++e) { const bool ok = !((taken >> e) & 1u) && (v[e] > best); best = ok ? v[e] : best; bi = ok ? e : bi; }
            taken |= 1u << bi; tv[k] = best; te[k] = bi;
        }
        float ex[4], es = 0.f;
#pragma unroll
        for (int k = 0; k < 4; ++k) { ex[k] = __expf(tv[k] - tv[0]); es += ex[k]; }
        int rk[4];
#pragma unroll
        for (int k = 0; k < 4; ++k) { TOPE[row * 4 + k] = te[k]; TOPW[row * 4 + k] = ex[k] / es; rk[k] = (int)__hip_atomic_fetch_add((LAS unsigned*)&lc[te[k]], 1u, __ATOMIC_RELAXED, __HIP_MEMORY_SCOPE_WORKGROUP); }
        __syncthreads();
        if (tid < 32) lc[64 + tid] = __hip_atomic_fetch_add(&CNT[tid], lc[tid], __ATOMIC_RELAXED, __HIP_MEMORY_SCOPE_AGENT);
        __syncthreads();
#pragma unroll
        for (int k = 0; k < 4; ++k) RANK[row * 4 + k] = (int)lc[64 + te[k]] + rk[k];
        __syncthreads();
    }
}
__device__ __forceinline__ void phase_norm2_route(const Args& a, Frame& F, int l) {
    const int lane = fresh_lane(), fr = lane & 15, fq = lane >> 4, tid = F.wave * 64 + lane;
    const bf16_t* X1 = (const bf16_t*)(F.ws + WS_X1);
    bf16_t* HC = (bf16_t*)(F.ws + WS_HC);
    const bf16_t* WRP = (const bf16_t*)(F.ws + WS_W + (size_t)l * WL_BYTES + WO_WRP);
    int* TOPE = (int*)(F.ws + WS_RT); float* TOPW = (float*)(F.ws + WS_RT + 512 * 1024); int* RANK = (int*)(F.ws + WS_RT + 1024 * 1024);
    unsigned* CNT = (unsigned*)(F.ctl + CW_MOE + l * CW_MOE_STRIDE);
    const float* br = a.in[I_BR] + (size_t)l * 32;
    volatile LAS unsigned* lc = F.MISC + 32;
    LAS float* gm = (LAS float*)F.lds; LAS float* shv = gm + 1024;
    LAS float* lt = (LAS float*)(F.lds + 8192) + F.wave * (16 * 33);
    const int b = (F.vcu * 128) / SEQ;
    const float* ada_b = (const float*)(F.ws + WS_ADA) + ((size_t)l * 8 + b) * 6144;
    const float* gam = a.in[I_N2G] + (size_t)l * DM;
    for (int i = tid; i < 1024; i += NTHREADS) { gm[i] = gam[i] * (1.f + ada_b[4096 + i]); shv[i] = ada_b[3072 + i]; }
    if (tid < 32) lc[tid] = 0u;
    LAS unsigned char* wrl = F.lds + 25600;
    { u32x4 wv[16];
#pragma unroll
      for (int i = 0; i < 16; ++i) { const int q = tid + NTHREADS * i, part = q >> 12, e = (q >> 7) & 31, c = q & 127;
        wv[i] = *(const u32x4*)(WRP + (size_t)e * 3072 + part * 2048 + c * 8); }
#pragma unroll
      for (int i = 0; i < 16; ++i) { const int q = tid + NTHREADS * i, part = q >> 12, e = (q >> 7) & 31, c = q & 127;
        *(LAS u32x4*)(wrl + part * 65536 + e * 2048 + ((c ^ (e & 15)) << 4)) = wv[i]; } }
    __syncthreads();
    const int row = F.gw * 16 + fr;
    const bf16_t* __restrict__ xr = X1 + (size_t)row * DM + 8 * fq;
#define LD_X8(v0, v1, p) const u32x4 _xb = *(const u32x4*)(p); const f32x4 v0 = {bf2f(_xb.x & 0xffffu), bf2f(_xb.x >> 16), bf2f(_xb.y & 0xffffu), bf2f(_xb.y >> 16)}, v1 = {bf2f(_xb.z & 0xffffu), bf2f(_xb.z >> 16), bf2f(_xb.w & 0xffffu), bf2f(_xb.w >> 16)}
    float ss = 0.f;
#pragma unroll 8
    for (int kk = 0; kk < 32; ++kk) { LD_X8(v0, v1, xr + 32 * kk);
        ss += (v0[0] * v0[0] + v0[1] * v0[1]) + (v0[2] * v0[2] + v0[3] * v0[3]) + (v1[0] * v1[0] + v1[1] * v1[1]) + (v1[2] * v1[2] + v1[3] * v1[3]); }
    ss += shfl_xor_f(ss, 16, lane); ss += shfl_xor_f(ss, 32, lane);
    const float rstd = 1.0f / sqrtf(ss * (1.f / DM) + RMS_EPS);
    f32x4 acc[2] = {(f32x4){0.f, 0.f, 0.f, 0.f}, (f32x4){0.f, 0.f, 0.f, 0.f}};
    bf16_t* __restrict__ hrow = HC + (size_t)row * 1024 + 8 * fq;
    const bf16_t* __restrict__ wb = WRP + (size_t)fr * 3072 + 8 * fq;
#pragma unroll 8
    for (int kk = 0; kk < 32; ++kk) {
        LD_X8(v0, v1, xr + 32 * kk);
        const f32x4 g0 = *(const LAS f32x4*)(gm + 32 * kk + 8 * fq), g1 = *(const LAS f32x4*)(gm + 32 * kk + 8 * fq + 4);
        const f32x4 s0 = *(const LAS f32x4*)(shv + 32 * kk + 8 * fq), s1 = *(const LAS f32x4*)(shv + 32 * kk + 8 * fq + 4);
        const f32x4 h0 = (v0 * rstd) * g0 + s0, h1 = (v1 * rstd) * g1 + s1;
        u32x4 H; H.x = pk2(h0[0], h0[1]); H.y = pk2(h0[2], h0[3]); H.z = pk2(h1[0], h1[1]); H.w = pk2(h1[2], h1[3]);
        *(u32x4*)(hrow + 32 * kk) = H;
        u32x4 Lo; Lo.x = pk2(h0[0] - bf2f(H.x & 0xffffu), h0[1] - bf2f(H.x >> 16)); Lo.y = pk2(h0[2] - bf2f(H.y & 0xffffu), h0[3] - bf2f(H.y >> 16));
        Lo.z = pk2(h1[0] - bf2f(H.z & 0xffffu), h1[1] - bf2f(H.z >> 16)); Lo.w = pk2(h1[2] - bf2f(H.w & 0xffffu), h1[3] - bf2f(H.w >> 16));
        const bf16x8 Ah = __builtin_bit_cast(bf16x8, H), Al = __builtin_bit_cast(bf16x8, Lo);
#pragma unroll
        for (int nt = 0; nt < 2; ++nt) {
            const int e = nt * 16 + fr; const LAS unsigned char* wp2 = wrl + e * 2048 + (((4 * kk + fq) ^ fr) << 4);
            const bf16x8 bh = *(const LAS bf16x8*)wp2, bl = *(const LAS bf16x8*)(wp2 + 65536);
            acc[nt] = __builtin_amdgcn_mfma_f32_16x16x32_bf16(Al, bh, acc[nt], 0, 0, 0);
            acc[nt] = __builtin_amdgcn_mfma_f32_16x16x32_bf16(Ah, bl, acc[nt], 0, 0, 0);
            acc[nt] = __builtin_amdgcn_mfma_f32_16x16x32_bf16(Ah, bh, acc[nt], 0, 0, 0);
        }
    }
#pragma unroll
    for (int nt = 0; nt < 2; ++nt) { const float bias = br[fr + 16 * nt];
#pragma unroll
        for (int r = 0; r < 4; ++r) lt[(4 * fq + r) * 33 + fr + 16 * nt] = acc[nt][r] + bias; }
    asm volatile("s_waitcnt lgkmcnt(0)" ::: "memory");
    int te[4] = {0, 0, 0, 0}, rk[4] = {0, 0, 0, 0};
    const int orow = F.gw * 16 + lane;
    if (lane < 16) {
        float v[32];
#pragma unroll
        for (int e = 0; e < 32; ++e) v[e] = lt[lane * 33 + e];
        unsigned taken = 0u; float tv[4];
#pragma unroll
        for (int k = 0; k < 4; ++k) {
            float best = -INFINITY; int bi = 0;
#pragma unroll
            for (int e = 0; e < 32; ++e) { const bool ok = !((taken >> e) & 1u) && (v[e] > best); best = ok ? v[e] : best; bi = ok ? e : bi; }
            taken |= 1u << bi; tv[k] = best; te[k] = bi;
        }
        float ex[4], es = 0.f;
#pragma unroll
        for (int k = 0; k < 4; ++k) { ex[k] = __expf(tv[k] - tv[0]); es += ex[k]; }
        const float inv = 1.f / es;
        *(int4*)(TOPE + orow * 4) = make_int4(te[0], te[1], te[2], te[3]);
        *(float4*)(TOPW + orow * 4) = make_float4(ex[0] * inv, ex[1] * inv, ex[2] * inv, ex[3] * inv);
#pragma unroll
        for (int k = 0; k < 4; ++k) rk[k] = (int)__hip_atomic_fetch_add((LAS unsigned*)&lc[te[k]], 1u, __ATOMIC_RELAXED, __HIP_MEMORY_SCOPE_WORKGROUP);
    }
    __syncthreads();
    if (tid < 32) lc[64 + tid] = __hip_atomic_fetch_add(&CNT[tid], lc[tid], __ATOMIC_RELAXED, __HIP_MEMORY_SCOPE_AGENT);
    __syncthreads();
    if (lane < 16) *(int4*)(RANK + orow * 4) = make_int4((int)lc[64 + te[0]] + rk[0], (int)lc[64 + te[1]] + rk[1], (int)lc[64 + te[2]] + rk[2], (int)lc[64 + te[3]] + rk[3]);
    __syncthreads();
}
__device__ __forceinline__ void phase_dispatch(Frame& F, int l) {
    const int* TOPE = (const int*)(F.ws + WS_RT); const int* RANK = (const int*)(F.ws + WS_RT + 1024 * 1024); int* DEST = (int*)(F.ws + WS_RT + 1536 * 1024);
    int* PERM = (int*)(F.ws + WS_RT + 2048 * 1024);
    unsigned* CNT = (unsigned*)(F.ctl + CW_MOE + l * CW_MOE_STRIDE);
    const int lane = fresh_lane();
    const int cnt = (lane < 32) ? (int)CNT[lane] : 0;
    const int padded = (cnt + 255) & ~255;
    int start = 0;
#pragma unroll
    for (int j = 0; j < 32; ++j) { const int pj = __builtin_amdgcn_readlane(padded, j); start += (j < lane) ? pj : 0; }
    if (F.vcu == 0 && F.wave == 0) {
        int* tinfo = (int*)(CNT);
        if (lane < 32) { const int nt = padded >> 8, tb = start >> 8; for (int j = 0; j < nt; ++j) tinfo[64 + tb + j] = lane;
            int pz = 0; asm volatile("" : "+v"(pz));
#pragma clang loop vectorize(disable) unroll(disable)
            for (int r = cnt; r < padded; ++r) PERM[start + r] = pz; }
        if (lane == 31) tinfo[32] = (start + padded) >> 8;
    }
    for (int as = F.gw * 64 + lane; as < NASG; as += F.NGW * 64) {
        const int e = TOPE[as];
        const int dest = __builtin_amdgcn_ds_bpermute(e << 2, start) + RANK[as];
        DEST[as] = dest; PERM[dest] = as >> 2;
    }
}
__device__ __forceinline__ void phase_combine(const Args& a, Frame& F, int l) {
    const bf16_t* __restrict__ X1 = (const bf16_t*)(F.ws + WS_X1); bf16_t* __restrict__ X = (bf16_t*)(F.ws + WS_X);
    const bf16_t* __restrict__ YS = (const bf16_t*)(F.ws + WS_YS);
    const float* __restrict__ TOPW = (const float*)(F.ws + WS_RT + 512 * 1024); const int* __restrict__ DEST = (const int*)(F.ws + WS_RT + 1536 * 1024);
    bf16_t* __restrict__ HCo = (bf16_t*)(F.ws + WS_HC); float* __restrict__ outp = a.out;
    const float* ada = (const float*)(F.ws + WS_ADA);
    const int lane = fresh_lane();
    for (int grp = F.gw; grp < NTOK / 16; grp += F.NGW) {
        const int b = (grp * 16) / SEQ;
        const float* g2 = ada + ((size_t)l * 8 + b) * 6144 + 5120;
        f32x4 g2v[4], gmv[4], shv[4], fgv[4];
#pragma unroll
        for (int j = 0; j < 4; ++j) { const int c = 4 * lane + 256 * j; g2v[j] = *(const f32x4*)(g2 + c);
            if (l + 1 < DEPTH) { const float* ab = ada + ((size_t)(l + 1) * 8 + b) * 6144;
                gmv[j] = *(const f32x4*)(a.in[I_N1G] + (size_t)(l + 1) * DM + c) * (*(const f32x4*)(ab + 1024 + c) + 1.f); shv[j] = *(const f32x4*)(ab + c); }
            else fgv[j] = *(const f32x4*)(a.in[I_FG] + c); }
        const int dall = DEST[grp * 64 + lane]; const float wall = TOPW[grp * 64 + lane];
#pragma unroll 2
        for (int rr = 0; rr < 16; ++rr) {
            const int row = grp * 16 + rr;
            float w4[4]; int d4[4];
#pragma unroll
            for (int k = 0; k < 4; ++k) { d4[k] = __builtin_amdgcn_readlane(dall, 4 * rr + k); w4[k] = __builtin_bit_cast(float, __builtin_amdgcn_readlane(__builtin_bit_cast(int, wall), 4 * rr + k)); }
            f32x4 m[4];
#pragma unroll
            for (int j = 0; j < 4; ++j) m[j] = (f32x4){0.f, 0.f, 0.f, 0.f};
#pragma unroll
            for (int k = 0; k < 4; ++k) {
                const bf16_t* yr = YS + (size_t)d4[k] * 1024 + 4 * lane;
#pragma unroll
                for (int j = 0; j < 4; ++j) { const u32x2 yv = *(const u32x2*)(yr + 256 * j);
                    m[j][0] += w4[k] * bf2f(yv.x & 0xffffu); m[j][1] += w4[k] * bf2f(yv.x >> 16); m[j][2] += w4[k] * bf2f(yv.y & 0xffffu); m[j][3] += w4[k] * bf2f(yv.y >> 16); }
            }
            f32x4 v[4]; float ss = 0.f;
#pragma unroll
            for (int j = 0; j < 4; ++j) { const int c = 4 * lane + 256 * j;
                const u32x2 xb = *(const u32x2*)(X1 + (size_t)row * DM + c);
                v[j] = (f32x4){bf2f(xb.x & 0xffffu), bf2f(xb.x >> 16), bf2f(xb.y & 0xffffu), bf2f(xb.y >> 16)} + g2v[j] * m[j];
                ss += (v[j][0] * v[j][0] + v[j][1] * v[j][1]) + (v[j][2] * v[j][2] + v[j][3] * v[j][3]); }
            const float rstd = 1.0f / sqrtf(wave_sum(ss) * (1.f / DM) + RMS_EPS);
            if (l + 1 < DEPTH) {
                f32x4 h[4];
#pragma unroll
                for (int j = 0; j < 4; ++j) { u32x2 xo; xo.x = pk2(v[j][0], v[j][1]); xo.y = pk2(v[j][2], v[j][3]); *(u32x2*)(X + (size_t)row * DM + 4 * lane + 256 * j) = xo; h[j] = (v[j] * rstd) * gmv[j] + shv[j]; }
                store_hilo(HCo + (size_t)row * 1024, lane, h);
            } else {
#pragma unroll
                for (int j = 0; j < 4; ++j) *(f32x4*)(outp + (size_t)row * DM + 4 * lane + 256 * j) = v[j] * rstd * fgv[j];
            }
        }
    }
}

constexpr int NPH = 11;
constexpr int NSTEPS = 1 + DEPTH * NPH;
__global__ void __launch_bounds__(NTHREADS, 2) fwd_kernel(Args args) {
    extern __shared__ __attribute__((aligned(16))) unsigned char lds_raw[];
    Frame F;
    F.lds = (LAS unsigned char*)lds_raw; F.MISC = (volatile LAS unsigned*)(F.lds + MISC_OFF);
    F.wave = __builtin_amdgcn_readfirstlane((int)threadIdx.x >> 6);
    F.G = 256; { const int bx = blockIdx.x; F.vcu = (bx & 7) * 32 + (bx >> 3); }
    F.gw = F.vcu * NWAVES + F.wave; F.NGW = F.G * NWAVES;
    F.ws = (GAS unsigned char*)args.ws; F.ctl = (GAS unsigned*)(args.ws + WS_CTL);
    for (int u = threadIdx.x; u < 256; u += NTHREADS) F.MISC[u] = 0u;
    __syncthreads();
    XcdBarrier bar; bar.bar = (unsigned*)(F.ctl + CW_BAR); bar.x = 0; bar.st = nullptr;
    if (args.use_bar) bar = xcd_barrier_post((unsigned*)(F.ctl + CW_BAR), F.MISC + 8);
    const int lo = args.ph_lo, hi = args.ph_hi;
#ifndef PH_MASK
#define PH_MASK 0xffffffffu
#endif
#define PHON(p) (((PH_MASK) >> (p)) & 1u)
#ifndef REP_MASK
#define REP_MASK 0u
#endif
#define NREP(p) ((((REP_MASK) >> (p)) & 1u) ? 2 : 1)
#define IN(k) (lo <= (k) && (k) < hi)
#define SEAM(k) do { if (IN(k) && IN((k) + 1)) xcd_barrier(bar); } while (0)
    if (PHON(11) && IN(0)) { phase_prologue(args, F); }
    SEAM(0);
    for (int l = 0; l < DEPTH; ++l) {
        int bx = blockIdx.x;
        { unsigned char* w2 = args.ws; int wv = F.wave; asm volatile("" : "+s"(w2), "+s"(bx), "+s"(wv)); F.ws = (GAS unsigned char*)w2; F.ctl = (GAS unsigned*)(w2 + WS_CTL); F.wave = wv;
          F.vcu = (bx & 7) * 32 + (bx >> 3); F.gw = F.vcu * NWAVES + F.wave; }
        const int s0 = 1 + l * NPH;
        GAS unsigned char* wl = F.ws + WS_W + (size_t)l * WL_BYTES;
        const float* ada_l = (const float*)(F.ws + WS_ADA) + (size_t)l * 8 * 6144;
        _Pragma("unroll 1") for (int rep = 0; rep < NREP(0); ++rep) if (PHON(0) && IN(s0 + 0)) { if (l == 0) phase_norm(F, args.in[I_X], args.in[I_N1G], ada_l, 0, 1024); }
        if (l == 0) SEAM(s0 + 0);
        _Pragma("unroll 1") for (int rep = 0; rep < NREP(1); ++rep) if (PHON(1) && IN(s0 + 1)) {
            pg8::Gemm g{(const bf16_t*)(F.ws + WS_HC), (const bf16_t*)(wl + WO_INMAIN), 1024, 1024, 1024, 0x7fffffff};
            pg8::StaticOrder S; S.init(NTOK, PM_LD, F.G, bx);
            pg8::EpiInMain E{(bf16_t*)(F.ws + WS_P)};
            pg8::gemm_phase<pg8::EpiInMain, pg8::StaticOrder>(F.lds, g, S, E, F.wave);
        }
        SEAM(s0 + 1);
        _Pragma("unroll 1") for (int rep = 0; rep < NREP(2); ++rep) if (PHON(2) && IN(s0 + 2)) phase_prep(args, F, l);
        SEAM(s0 + 2);
        _Pragma("unroll 1") for (int rep = 0; rep < NREP(3); ++rep) if (PHON(3) && IN(s0 + 3)) phase_attention(args, F, l);
        SEAM(s0 + 3);
        _Pragma("unroll 1") for (int rep = 0; rep < NREP(4); ++rep) if (PHON(4) && IN(s0 + 4)) {
            pg8::Gemm g{(const bf16_t*)(F.ws + WS_OAB), (const bf16_t*)(wl + WO_WA), 1024, 1024, 1024, 0x7fffffff};
            pg8::StaticOrder S; S.init(NTOK, 1024, F.G, bx);
            pg8::EpiGate E{(bf16_t*)(F.ws + WS_MG), (const bf16_t*)(F.ws + WS_P)};
            pg8::gemm_phase<pg8::EpiGate, pg8::StaticOrder>(F.lds, g, S, E, F.wave);
        }
        SEAM(s0 + 4);
        _Pragma("unroll 1") for (int rep = 0; rep < NREP(5); ++rep) if (PHON(5) && IN(s0 + 5)) {
            pg8::Gemm g{(const bf16_t*)(F.ws + WS_MG), (const bf16_t*)(wl + WO_WOUT), 1024, 1024, 1024, 0x7fffffff};
            pg8::StaticOrder S; S.init(NTOK, 1024, F.G, bx);
            if (l == 0) { pg8::EpiWout<false> E{(bf16_t*)(F.ws + WS_X1), (const void*)args.in[I_X], ada_l + 2048};
                pg8::gemm_phase<pg8::EpiWout<false>, pg8::StaticOrder>(F.lds, g, S, E, F.wave); }
            else { pg8::EpiWout<true> E{(bf16_t*)(F.ws + WS_X1), (const void*)(F.ws + WS_X), ada_l + 2048};
                pg8::gemm_phase<pg8::EpiWout<true>, pg8::StaticOrder>(F.lds, g, S, E, F.wave); }
        }
        SEAM(s0 + 5);
        _Pragma("unroll 1") for (int rep = 0; rep < NREP(6); ++rep) if (PHON(6) && IN(s0 + 6)) phase_norm2_route(args, F, l);
        SEAM(s0 + 6);
        _Pragma("unroll 1") for (int rep = 0; rep < NREP(7); ++rep) if (PHON(7) && IN(s0 + 7)) phase_dispatch(F, l);
        SEAM(s0 + 7);
        _Pragma("unroll 1") for (int rep = 0; rep < NREP(8); ++rep) if (PHON(8) && IN(s0 + 8)) {
            const int* tinfo = (const int*)(F.ctl + CW_MOE + l * CW_MOE_STRIDE);
            pg8::Gemm g{(const bf16_t*)(F.ws + WS_HC), (const bf16_t*)(wl + WO_WGU), 1024, 1024, 1024, 0x7fffffff, (const int*)(F.ws + WS_RT + 2048 * 1024)};
            pg8::GroupedOrder S{tinfo + 64, tinfo[32], F.G, F.vcu};
            pg8::EpiGU E{(bf16_t*)(F.ws + WS_ACT), args.in[I_BGU] + (size_t)l * 32 * 1024};
            pg8::gemm_phase<pg8::EpiGU, pg8::GroupedOrder, true>(F.lds, g, S, E, F.wave);
        }
        SEAM(s0 + 8);
        _Pragma("unroll 1") for (int rep = 0; rep < NREP(9); ++rep) if (PHON(9) && IN(s0 + 9)) {
            const int* tinfo = (const int*)(F.ctl + CW_MOE + l * CW_MOE_STRIDE);
            pg8::Gemm g{(const bf16_t*)(F.ws + WS_ACT), (const bf16_t*)(wl + WO_WDN), 512, 512, 512, 0x7fffffff};
            pg8::GroupedOrder S{tinfo + 64, tinfo[32], F.G, F.vcu};
            pg8::EpiDown E{(bf16_t*)(F.ws + WS_YS), args.in[I_BDN] + (size_t)l * 32 * 1024};
            pg8::gemm_phase<pg8::EpiDown, pg8::GroupedOrder>(F.lds, g, S, E, F.wave);
        }
        SEAM(s0 + 9);
        _Pragma("unroll 1") for (int rep = 0; rep < NREP(10); ++rep) if (PHON(10) && IN(s0 + 10)) phase_combine(args, F, l);
        SEAM(s0 + 10);
    }
}

extern "C" void kernel_launch(void* const* d_in, const int* in_sizes, int n_in, void* d_out, int out_size, void* d_ws, size_t ws_size, hipStream_t stream) {
    static int grid = 0;
    if (grid == 0) {
        if (n_in != 22 || ws_size < WS_END) { fprintf(stderr, "kernel_launch: unexpected inputs (n_in %d, ws %zu)\n", n_in, ws_size); grid = -1; return; }
        int dev = 0, cus = 0, per_cu = 0;
        if (hipGetDevice(&dev) != hipSuccess || hipDeviceGetAttribute(&cus, hipDeviceAttributeMultiprocessorCount, dev) != hipSuccess) { grid = -1; return; }
        if (hipFuncSetAttribute((const void*)fwd_kernel, hipFuncAttributeMaxDynamicSharedMemorySize, LDS_BYTES) != hipSuccess) { fprintf(stderr, "kernel_launch: hipFuncSetAttribute failed\n"); grid = -1; return; }
        if (hipOccupancyMaxActiveBlocksPerMultiprocessor(&per_cu, (const void*)fwd_kernel, NTHREADS, LDS_BYTES) != hipSuccess || per_cu < 1) fprintf(stderr, "kernel_launch: occupancy query says %d\n", per_cu);
        (void)hipGetLastError();
        if (cus < 256) { fprintf(stderr, "kernel_launch: needs 256 CUs, device has %d\n", cus); grid = -1; return; }
        grid = 256;
    }
    if (grid < 0) return;
    (void)hipMemsetAsync((char*)d_ws + WS_CTL, 0, CTL_BYTES, stream);
    Args a; memset(&a, 0, sizeof(a));
    for (int i = 0; i < 22; ++i) a.in[i] = (const float*)d_in[i];
    a.out = (float*)d_out; a.ws = (unsigned char*)d_ws;
#if MK_MULTI
    a.use_bar = 0;
    for (int s = 0; s < NSTEPS; ++s) {
        if (s > 0) { const int l = (s - 1) / NPH, p = (s - 1) % NPH; if (p == 0 && l > 0) continue; }
        a.ph_lo = s; a.ph_hi = s + 1;
        hipLaunchKernelGGL(fwd_kernel, dim3(grid), dim3(NTHREADS), LDS_BYTES, stream, a);
#ifdef HOST_REP_MASK
        if ((s > 0 && ((HOST_REP_MASK >> ((s - 1) % NPH)) & 1)) || (s == 0 && ((HOST_REP_MASK >> 30) & 1))) hipLaunchKernelGGL(fwd_kernel, dim3(grid), dim3(NTHREADS), LDS_BYTES, stream, a);
#endif
    }
#else
    a.use_bar = 1; a.ph_lo = 0; a.ph_hi = NSTEPS;
    hipLaunchKernelGGL(fwd_kernel, dim3(grid), dim3(NTHREADS), LDS_BYTES, stream, a);
#endif
}
```
